# Optimizing an MI355X kernel written in HIP

```python
import jax, jax.numpy as jnp
from jax import lax
import numpy as np

D_MODEL = 2048
BATCH = 4
SEQ = 8192
DEPTH = 1
DEC_BATCH = 32
DEC_SEQ = 16
PAST_LEN = 2048

CHUNK = 64
N_LEFT_CHUNKS = 8
KV_WINDOW = N_LEFT_CHUNKS * CHUNK
BAND = KV_WINDOW + CHUNK
D_ATTN = D_MODEL // 2
N_HEADS_A = 8
HEAD_DIM = D_ATTN // N_HEADS_A
MAX_REL = 256
D_SGU = D_MODEL // 2
N_GROUPS_B = 8
GROUP_DIM_B = D_SGU // N_GROUPS_B
SGU_CHUNK = 128
D_FF = 5632
CONV_W = 3
EPS = 1e-6
SPLITS = (D_ATTN, 2 * D_ATTN, 3 * D_ATTN, 3 * D_ATTN + D_SGU, 3 * D_ATTN + 2 * D_SGU,
          3 * D_ATTN + 2 * D_SGU + D_MODEL)
D_IN = 3 * D_ATTN + 2 * D_SGU + 2 * D_MODEL

kernel_name = "hybrid_chunk_attn_sgu_convffn_step"


def rms_norm(x, g):
    x32 = x.astype(jnp.float32)
    inv = lax.rsqrt(jnp.mean(x32 * x32, axis=-1, keepdims=True) + EPS)
    return (x32 * inv).astype(x.dtype) * g


def mixer_inputs(x, norm_g, w_in, sgu_norm_g):
    B, T, _ = x.shape
    xn = rms_norm(x, norm_g)
    h = xn @ w_in
    q, k, v, u, vb, ga, gb = jnp.split(h, SPLITS, axis=-1)
    heads = lambda t: t.reshape(B, T, N_HEADS_A, HEAD_DIM)
    u = jax.nn.gelu(u, approximate=False)
    vb = rms_norm(jax.nn.gelu(vb, approximate=False), sgu_norm_g)
    return heads(q), heads(k), heads(v), u, vb, ga, gb


def band_attention(q, k, v, bias, mask):
    s = jnp.einsum('bqhd,bkhd->bhqk', q, k).astype(jnp.float32) * (HEAD_DIM ** -0.5)
    s = jnp.where(mask, s + bias.astype(jnp.float32), -1e30)
    p = jax.nn.softmax(s, axis=-1).astype(v.dtype)
    return jnp.einsum('bhqk,bkhd->bqhd', p, v)


def rel_bias_lookup(rel_bias, dist):
    return rel_bias[:, jnp.clip(dist, -MAX_REL, MAX_REL) + MAX_REL]


def chunk_attention_prompt(q, k, v, rel_bias):
    B, T, H, Dh = q.shape
    nc = T // CHUNK
    pad = ((0, 0), (KV_WINDOW, 0), (0, 0), (0, 0))
    kp, vp = jnp.pad(k, pad), jnp.pad(v, pad)
    i = jnp.arange(CHUNK)[:, None]
    j = jnp.arange(BAND)[None, :]
    bias = rel_bias_lookup(rel_bias, i - j + KV_WINDOW)
    qc = q.reshape(B, nc, CHUNK, H, Dh).transpose(1, 0, 2, 3, 4)

    def one_chunk(args):
        c, q_blk = args
        start = c * CHUNK
        k_band = lax.dynamic_slice_in_dim(kp, start, BAND, axis=1)
        v_band = lax.dynamic_slice_in_dim(vp, start, BAND, axis=1)
        k_pos = start - KV_WINDOW + jnp.arange(BAND)
        mask = jnp.broadcast_to((k_pos >= 0)[None, :], (CHUNK, BAND))
        return band_attention(q_blk, k_band, v_band, bias, mask)

    out = lax.map(one_chunk, (jnp.arange(nc), qc))
    return out.transpose(1, 0, 2, 3, 4).reshape(B, T, H * Dh)


def chunk_attention_sample(q, k_new, v_new, k_cache, v_cache, rel_bias):
    B, S, H, Dh = q.shape
    L = k_cache.shape[1]
    k = jnp.concatenate([k_cache, k_new], axis=1)
    v = jnp.concatenate([v_cache, v_new], axis=1)
    q_pos = PAST_LEN + jnp.arange(S)
    k_pos = jnp.concatenate([PAST_LEN - L + jnp.arange(L), PAST_LEN + jnp.arange(S)])
    cq = q_pos[:, None] // CHUNK
    ck = k_pos[None, :] // CHUNK
    mask = (ck <= cq) & (cq - ck <= N_LEFT_CHUNKS)
    bias = rel_bias_lookup(rel_bias, q_pos[:, None] - k_pos[None, :])
    return band_attention(q, k, v, bias, mask).reshape(B, S, H * Dh)


def causal_sgu_weights(w_s):
    return w_s * jnp.tril(jnp.ones((SGU_CHUNK, SGU_CHUNK), w_s.dtype))


def sgu_prompt(u, vb, w_s, b_s):
    B, T, _ = vb.shape
    nc = T // SGU_CHUNK
    vg = vb.reshape(B, nc, SGU_CHUNK, N_GROUPS_B, GROUP_DIM_B)
    mixed = jnp.einsum('gij,bcjgd->bcigd', causal_sgu_weights(w_s), vg)
    mixed = mixed + b_s.T[None, None, :, :, None]
    return u * mixed.reshape(B, T, D_SGU)


def sgu_sample(u, vb, w_s, b_s):
    B, S, _ = vb.shape
    vg = vb.reshape(B, S, N_GROUPS_B, GROUP_DIM_B)
    w = causal_sgu_weights(w_s)[:, :S, :S]
    mixed = jnp.einsum('gij,bjgd->bigd', w, vg) + b_s[:, :S].T[None, :, :, None]
    return u * mixed.reshape(B, S, D_SGU)


def merge_branches(x, a, s, ga, gb, w_branch_a, w_branch_b, w_out):
    m = jax.nn.sigmoid(ga) * (a @ w_branch_a) + jax.nn.sigmoid(gb) * (s @ w_branch_b)
    return x + m @ w_out


def conv_ffn(x, h_hist, norm_g, w_up, conv_w, conv_b, w_down):
    T = x.shape[1]
    h = rms_norm(x, norm_g) @ w_up
    h_ext = jnp.concatenate([h_hist, h], axis=1)
    hc = conv_b + sum(conv_w[t] * h_ext[:, t:t + T] for t in range(CONV_W))
    gate, val = jnp.split(hc, 2, axis=-1)
    y = x + (jax.nn.gelu(gate, approximate=False) * val) @ w_down
    return y, h_ext[:, -(CONV_W - 1):]


def layer_prompt(x, norm_mix_g, w_in, rel_bias, sgu_norm_g, w_s, b_s, w_branch_a, w_branch_b,
                 w_out, norm_ffn_g, w_up, conv_w, conv_b, w_down):
    B, T, _ = x.shape
    q, k, v, u, vb, ga, gb = mixer_inputs(x, norm_mix_g, w_in, sgu_norm_g)
    a = chunk_attention_prompt(q, k, v, rel_bias)
    s = sgu_prompt(u, vb, w_s, b_s)
    x = merge_branches(x, a, s, ga, gb, w_branch_a, w_branch_b, w_out)
    h_hist = jnp.zeros((B, CONV_W - 1, 2 * D_FF), x.dtype)
    x, conv_state = conv_ffn(x, h_hist, norm_ffn_g, w_up, conv_w, conv_b, w_down)
    keep = min(KV_WINDOW, T)
    return x, k[:, T - keep:], v[:, T - keep:], conv_state


def layer_sample(x, k_cache, v_cache, conv_cache, norm_mix_g, w_in, rel_bias, sgu_norm_g, w_s, b_s,
                 w_branch_a, w_branch_b, w_out, norm_ffn_g, w_up, conv_w, conv_b, w_down):
    q, k, v, u, vb, ga, gb = mixer_inputs(x, norm_mix_g, w_in, sgu_norm_g)
    a = chunk_attention_sample(q, k, v, k_cache, v_cache, rel_bias)
    s = sgu_sample(u, vb, w_s, b_s)
    x = merge_branches(x, a, s, ga, gb, w_branch_a, w_branch_b, w_out)
    x, conv_state = conv_ffn(x, conv_cache, norm_ffn_g, w_up, conv_w, conv_b, w_down)
    return x, k, v, vb, conv_state


def setup_inputs(seed: int = 0) -> dict:
    key = jax.random.key(seed)
    ks = jax.random.split(key, 24)
    f32 = jnp.float32
    nrm = lambda k, shape, scale: jax.random.normal(k, shape, f32) * scale
    L = min(KV_WINDOW, PAST_LEN)
    return {
        "x_prompt": nrm(ks[0], (BATCH, SEQ, D_MODEL), 1.0),
        "x_sample": nrm(ks[1], (DEC_BATCH, DEC_SEQ, D_MODEL), 1.0),
        "cache_k": nrm(ks[2], (DEPTH, DEC_BATCH, L, N_HEADS_A, HEAD_DIM), 1.0),
        "cache_v": nrm(ks[3], (DEPTH, DEC_BATCH, L, N_HEADS_A, HEAD_DIM), 1.0),
        "cache_ffn_conv": nrm(ks[4], (DEPTH, DEC_BATCH, CONV_W - 1, 2 * D_FF), 1.0),
        "norm_mix_g": 1.0 + nrm(ks[5], (DEPTH, D_MODEL), 0.02),
        "w_in": nrm(ks[6], (DEPTH, D_MODEL, D_IN), D_MODEL ** -0.5),
        "rel_bias": nrm(ks[7], (DEPTH, N_HEADS_A, 2 * MAX_REL + 1), 0.5),
        "sgu_norm_g": 1.0 + nrm(ks[8], (DEPTH, D_SGU), 0.02),
        "w_s": nrm(ks[9], (DEPTH, N_GROUPS_B, SGU_CHUNK, SGU_CHUNK), SGU_CHUNK ** -0.5),
        "b_s": 1.0 + nrm(ks[10], (DEPTH, N_GROUPS_B, SGU_CHUNK), 0.1),
        "w_branch_a": nrm(ks[11], (DEPTH, D_ATTN, D_MODEL), D_ATTN ** -0.5),
        "w_branch_b": nrm(ks[12], (DEPTH, D_SGU, D_MODEL), D_SGU ** -0.5),
        "w_out": nrm(ks[13], (DEPTH, D_MODEL, D_MODEL), D_MODEL ** -0.5),
        "norm_ffn_g": 1.0 + nrm(ks[14], (DEPTH, D_MODEL), 0.02),
        "w_up": nrm(ks[15], (DEPTH, D_MODEL, 2 * D_FF), D_MODEL ** -0.5),
        "conv_w": nrm(ks[16], (DEPTH, CONV_W, 2 * D_FF), CONV_W ** -0.5),
        "conv_b": nrm(ks[17], (DEPTH, 2 * D_FF), 0.01),
        "w_down": nrm(ks[18], (DEPTH, D_FF, D_MODEL), D_FF ** -0.5),
        "norm_final_g": 1.0 + nrm(ks[19], (D_MODEL,), 0.02),
    }


def reference(x_prompt, x_sample, cache_k, cache_v, cache_ffn_conv, norm_mix_g, w_in, rel_bias,
              sgu_norm_g, w_s, b_s, w_branch_a, w_branch_b, w_out, norm_ffn_g, w_up, conv_w, conv_b,
              w_down, norm_final_g):
    yp, ys = x_prompt, x_sample
    nk_p, nv_p, nc_p, nk_s, nv_s, nvb_s, nc_s = [], [], [], [], [], [], []
    for l in range(DEPTH):
        lp = (norm_mix_g[l], w_in[l], rel_bias[l], sgu_norm_g[l], w_s[l], b_s[l], w_branch_a[l],
              w_branch_b[l], w_out[l], norm_ffn_g[l], w_up[l], conv_w[l], conv_b[l], w_down[l])
        yp, kp_, vp_, cp_ = layer_prompt(yp, *lp)
        ys, ks_, vs_, vbs_, cs_ = layer_sample(ys, cache_k[l], cache_v[l], cache_ffn_conv[l], *lp)
        nk_p.append(kp_); nv_p.append(vp_); nc_p.append(cp_)
        nk_s.append(ks_); nv_s.append(vs_); nvb_s.append(vbs_); nc_s.append(cs_)
    y_prompt = rms_norm(yp, norm_final_g)
    y_sample = rms_norm(ys, norm_final_g)
    new_k_prompt = jnp.stack(nk_p)
    new_v_prompt = jnp.stack(nv_p)
    new_k_sample = jnp.stack(nk_s)
    new_v_sample = jnp.stack(nv_s)
    new_sgu_v_sample = jnp.stack(nvb_s)
    new_conv_prompt = jnp.stack(nc_p)
    new_conv_sample = jnp.stack(nc_s)
    return (y_prompt, y_sample, new_k_prompt, new_v_prompt, new_k_sample, new_v_sample,
            new_sgu_v_sample, new_conv_prompt, new_conv_sample)
```

```cpp
#include <hip/hip_runtime.h>
#include <hip/hip_cooperative_groups.h>
#include <cstdio>
namespace cg = cooperative_groups;

#ifndef ONE_LAUNCH
#define ONE_LAUNCH 1
#endif

#define LAS __attribute__((address_space(3)))
typedef unsigned short bf16_t;
typedef short bf16x8 __attribute__((ext_vector_type(8)));
typedef float f32x4 __attribute__((ext_vector_type(4)));
typedef float f32x2 __attribute__((ext_vector_type(2)));
typedef unsigned u32x4 __attribute__((ext_vector_type(4)));
typedef unsigned u32x2 __attribute__((ext_vector_type(2)));

namespace C {
constexpr int MP = 32768, MS = 512, M = 33280, D = 2048, DIN = 9216, DH = 1024, DFF = 5632, DFF2 = 11264, MPAD = 33344, TP = 8192;
constexpr int VTS_LD = 544;
constexpr float EPS = 1e-6f;
constexpr size_t O_Y = 0, O_KP = 68157440, O_VP = 70254592, O_KS = 72351744, O_VS = 72876032, O_SGU = 73400320, O_CP = 73924608, O_CS = 74014720;
constexpr size_t W_SS1 = 0, W_SS2 = 147456, W_SS3 = 294912, W_WSB = 442368;
constexpr size_t W_WIN = 1048576, W_WA = 38797312, W_WB = 42991616, W_WO = 47185920, W_WUP = 55574528, W_WD = 101711872;
constexpr size_t W_QB = 125829120, W_KB = 193986560, W_X1G = W_QB;
constexpr size_t W_B0 = 262144000;
constexpr size_t W_XN = W_B0, W_MB = W_B0, W_VT = 398458880, W_VTS = 465567744, W_UB = 501219328, W_GVBT = 569376768, W_SG = 637665280, W_SB = 910295040;
constexpr size_t W_H = W_B0, W_ACT = 642777088;
constexpr int HALF_ROWS = 16384;
}

__device__ __forceinline__ unsigned cvt_pk_bf16(float lo, float hi) { unsigned r; asm("v_cvt_pk_bf16_f32 %0, %1, %2" : "=v"(r) : "v"(lo), "v"(hi)); return r; }
__device__ __forceinline__ float bf_lo(unsigned w) { return __uint_as_float(w << 16); }
__device__ __forceinline__ float bf_hi(unsigned w) { return __uint_as_float(w & 0xffff0000u); }
__device__ __forceinline__ f32x4 mfma16(bf16x8 a, bf16x8 b, f32x4 c) { return __builtin_amdgcn_mfma_f32_16x16x32_bf16(a, b, c, 0, 0, 0); }
__device__ __forceinline__ bf16x8 pack8(f32x4 a, f32x4 b) { u32x4 w = {cvt_pk_bf16(a[0], a[1]), cvt_pk_bf16(a[2], a[3]), cvt_pk_bf16(b[0], b[1]), cvt_pk_bf16(b[2], b[3])}; return *reinterpret_cast<bf16x8*>(&w); }
__device__ __forceinline__ u32x4 pack8u(f32x4 a, f32x4 b) { u32x4 w = {cvt_pk_bf16(a[0], a[1]), cvt_pk_bf16(a[2], a[3]), cvt_pk_bf16(b[0], b[1]), cvt_pk_bf16(b[2], b[3])}; return w; }
__device__ __forceinline__ f32x2 gelu_pk(f32x2 v) {
    const f32x2 av = __builtin_elementwise_abs(v), d = av * 0.2316418882f + 1.0f;
    f32x2 t; t.x = __builtin_amdgcn_rcpf(d.x); t.y = __builtin_amdgcn_rcpf(d.y);
    f32x2 q = t * 0.5307027145f + (-0.7265760135f); q = q * t + 0.7107068705f; q = q * t + (-0.142248368f); q = q * t + 0.127414796f; q = q * t;
    const f32x2 s = (v * v) * (-0.72134752044f);
    f32x2 e; e.x = __builtin_amdgcn_exp2f(s.x); e.y = __builtin_amdgcn_exp2f(s.y);
    const f32x2 m = v * (q * e), r = v - m;
    f32x2 o; o.x = v.x < 0.f ? m.x : r.x; o.y = v.y < 0.f ? m.y : r.y; return o;
}
__device__ __forceinline__ f32x4 gelu4(f32x4 v) { f32x2 a = gelu_pk((f32x2){v[0], v[1]}), b = gelu_pk((f32x2){v[2], v[3]}); return (f32x4){a.x, a.y, b.x, b.y}; }
__device__ __forceinline__ float sigmoidf_(float x) { return __builtin_amdgcn_rcpf(1.0f + __builtin_amdgcn_exp2f(-1.4426950408889634f * x)); }
__device__ __forceinline__ f32x4 sigmoid4(f32x4 v) { return (f32x4){sigmoidf_(v[0]), sigmoidf_(v[1]), sigmoidf_(v[2]), sigmoidf_(v[3])}; }
__device__ __forceinline__ float dot4(f32x4 a) { return (a[0] * a[0] + a[1] * a[1]) + (a[2] * a[2] + a[3] * a[3]); }

struct Ptrs {
    const float *x_prompt, *x_sample, *cache_k, *cache_v, *cache_conv, *norm_mix_g, *w_in, *rel_bias, *sgu_norm_g, *w_s, *b_s, *w_a, *w_b, *w_out, *norm_ffn_g, *w_up, *conv_w, *conv_b, *w_down, *norm_final_g;
    float* out; unsigned char* ws;
};
struct Params { const float* in[20]; float* out; unsigned char* ws; int ph_lo, ph_hi; };

namespace pg8 {
constexpr int BM = 256, BK = 64, HALF = 128, HTB = HALF * BK * 2, STAGE_BYTES = 8 * HTB, NXCD = 8, WGM = 4;
__device__ __forceinline__ int lds_byte(int r, int c) { const int st = (r >> 4) * 2 + (c >> 5), rr = r & 15, cc = c & 31, ob = rr * 64 + cc * 2; return st * 1024 + (ob ^ (((ob >> 9) & 1) << 5)); }
__device__ __forceinline__ void stage_rc(int b, int& R, int& Cc) { const int st = b / 1024, sb = b % 1024, swz = sb ^ (((sb >> 9) & 1) << 5); R = (st >> 1) * 16 + swz / 64; Cc = (st & 1) * 32 + (swz % 64) / 2; }
__device__ __forceinline__ int perm32(int rho) { const int n = rho >> 4, i = rho & 15; return 8 * (i >> 2) + 4 * n + (i & 3); }

struct Unit { int pm, pn, sub; };
struct Gemm { const bf16_t *A0, *A1, *A2, *A3, *B0, *B1, *B2, *B3; int K; int ldk;
    __device__ __forceinline__ const bf16_t* pa(int s) const { return s == 0 ? A0 : (s == 1 ? A1 : (s == 2 ? A2 : A3)); }
    __device__ __forceinline__ const bf16_t* pb(int s) const { return s == 0 ? B0 : (s == 1 ? B1 : (s == 2 ? B2 : B3)); } };

struct Sched {
    int pm0, nM, nN, nsub, G, c;
    __device__ __forceinline__ bool next(int i, Unit& u) const {
        const int ii = i / nsub, sub = i - ii * nsub; const int nwg = nM * nN;
        const long L = (long)ii * G + c; if (L >= nwg) return false;
        int wgid = (int)L; { const int q = nwg / NXCD, r = nwg % NXCD, xcd = wgid % NXCD, off = wgid / NXCD; wgid = (xcd < r ? xcd * (q + 1) : r * (q + 1) + (xcd - r) * q) + off; }
        const int nig = WGM * nN, gid = wgid / nig, fm = gid * WGM, gsz = (nM - fm) < WGM ? (nM - fm) : WGM;
        u.pm = pm0 + fm + ((wgid % nig) % gsz); u.pn = (wgid % nig) / gsz; u.sub = sub; return true;
    }
};

struct SchedK4 {
    int G, c;
    __device__ __forceinline__ bool next(int i, Unit& u) const { const int L = i * G + c; if (L >= 64) return false; const int tile = L >> 2; u.pm = 128 + (tile & 1); u.pn = tile >> 1; u.sub = L & 3; return true; }
};
template <class Epi, class SchedT>
__device__ __forceinline__ void gemm_phase(LAS unsigned char* lds, const Gemm g, const SchedT& S, const Epi& E) {
    const int tid = threadIdx.x, wid = __builtin_amdgcn_readfirstlane(tid >> 6), lane = tid & 63, wr = wid >> 2, wc = wid & 3, fr = lane & 15, fq = lane >> 4;
    const int K = g.ldk, nt = g.K / BK;
    unsigned voffA[2], voffB[2];
#pragma unroll
    for (int i = 0; i < 2; ++i) { int R, Cc; stage_rc(tid * 16 + i * 8192, R, Cc); const int Rb = (R & ~31) + perm32(R & 31);
        voffA[i] = (unsigned)(R * K + Cc) * 2u; voffB[i] = (unsigned)(Rb * K + Cc) * 2u; }
    const size_t kstep = (size_t)(BK * 2);
    const size_t hstep = (size_t)HALF * K * 2;
    const size_t tstep = 2 * hstep;
    const unsigned ldsw = (unsigned)wid * 1024u;
    const int aoff = lds_byte(wr * 64 + fr, fq * 8), boff = lds_byte(wc * 32 + fr, fq * 8);
#define PG8_SA(b, h) (((b) * 2 + (h)) * HTB)
#define PG8_SB(b, h) ((4 + (b) * 2 + (h)) * HTB)
#define PG8_STAGE(bufoff, gbase, voff) do { _Pragma("unroll") for (int _i = 0; _i < 2; ++_i) \
        __builtin_amdgcn_global_load_lds((const unsigned*)((const char*)(gbase) + (voff)[_i]), (LAS unsigned*)(lds + (bufoff) + ldsw + _i * 8192), 16, 0, 0); } while (0)
#define PG8_LDA(dst, b, h) do { _Pragma("unroll") for (int m = 0; m < 4; ++m) _Pragma("unroll") for (int k = 0; k < 2; ++k) dst[m][k] = *(const LAS bf16x8*)(lds + PG8_SA(b, h) + aoff + m * 2048 + k * 1024); } while (0)
#define PG8_LDB(dst, b, h) do { _Pragma("unroll") for (int n = 0; n < 2; ++n) _Pragma("unroll") for (int k = 0; k < 2; ++k) dst[n][k] = *(const LAS bf16x8*)(lds + PG8_SB(b, h) + boff + n * 2048 + k * 1024); } while (0)
#define PG8_MMA(ai, bj, At, Bt) do { __builtin_amdgcn_s_setprio(1); _Pragma("unroll") for (int m = 0; m < 4; ++m) _Pragma("unroll") for (int n = 0; n < 2; ++n) _Pragma("unroll") for (int k = 0; k < 2; ++k) \
        acc[ai][bj][m][n] = __builtin_amdgcn_mfma_f32_16x16x32_bf16(Bt[n][k], At[m][k], acc[ai][bj][m][n], 0, 0, 0); __builtin_amdgcn_s_setprio(0); } while (0)
#define PG8_WAIT_V(n) asm volatile("s_waitcnt vmcnt(" #n ")" ::: "memory")
#define PG8_WAIT_L(n) asm volatile("s_waitcnt lgkmcnt(" #n ")" ::: "memory")
#define PG8_BAR __builtin_amdgcn_s_barrier()
#define PG8_SCHED __builtin_amdgcn_sched_barrier(0)
    Unit cur, nxt; int ui = 0;
    if (!S.next(0, cur)) return;
    f32x4 acc[2][2][4][2];
#pragma unroll
    for (int a = 0; a < 2; ++a)
#pragma unroll
        for (int b = 0; b < 2; ++b)
#pragma unroll
            for (int m = 0; m < 4; ++m)
#pragma unroll
                for (int n = 0; n < 2; ++n) acc[a][b][m][n] = (f32x4){0.f, 0.f, 0.f, 0.f};
    bf16x8 At[4][2], B0[2][2], B1[2][2];
    const char* cA = (const char*)g.pa(cur.sub) + (size_t)cur.pm * tstep; const char* cB = (const char*)g.pb(cur.sub) + (size_t)cur.pn * tstep;
    PG8_STAGE(PG8_SB(0, 0), cB, voffB); PG8_STAGE(PG8_SA(0, 0), cA, voffA); PG8_STAGE(PG8_SB(0, 1), cB + hstep, voffB); PG8_STAGE(PG8_SA(0, 1), cA + hstep, voffA);
    if (wr == 1) PG8_BAR;
    PG8_WAIT_V(4); PG8_BAR;
    PG8_STAGE(PG8_SB(1, 0), cB + kstep, voffB); PG8_STAGE(PG8_SA(1, 0), cA + kstep, voffA); PG8_STAGE(PG8_SB(1, 1), cB + hstep + kstep, voffB);
    PG8_WAIT_V(6); PG8_BAR;
    for (;;) {
        const bool has_next = S.next(ui + 1, nxt);
        const char* nA = has_next ? (const char*)g.pa(nxt.sub) + (size_t)nxt.pm * tstep : cA; const char* nB = has_next ? (const char*)g.pb(nxt.sub) + (size_t)nxt.pn * tstep : cB;
        for (int t = 0; t < nt; t += 2) {
            const bool last = (t == nt - 2);
            const char* a1 = cA + (size_t)(t + 1) * kstep;
            const char* a2 = last ? nA : cA + (size_t)(t + 2) * kstep; const char* b2 = last ? nB : cB + (size_t)(t + 2) * kstep;
            const char* a3 = a2 + kstep; const char* b3 = b2 + kstep;
            PG8_LDB(B0, 0, 0); PG8_SCHED; PG8_LDA(At, 0, 0); PG8_STAGE(PG8_SA(1, 1), a1 + hstep, voffA);
            PG8_WAIT_L(8); PG8_BAR; PG8_WAIT_L(0); PG8_MMA(0, 0, At, B0); PG8_BAR; PG8_SCHED;
            PG8_LDB(B1, 0, 1); PG8_STAGE(PG8_SB(0, 0), b2, voffB);
            PG8_BAR; PG8_WAIT_L(0); PG8_MMA(0, 1, At, B1); PG8_BAR;
            PG8_LDA(At, 0, 1); PG8_STAGE(PG8_SA(0, 0), a2, voffA);
            PG8_BAR; PG8_WAIT_L(0); PG8_MMA(1, 0, At, B0); PG8_BAR; PG8_SCHED;
            PG8_STAGE(PG8_SB(0, 1), b2 + hstep, voffB);
            PG8_WAIT_V(6); PG8_BAR; PG8_MMA(1, 1, At, B1); PG8_BAR;
            PG8_LDB(B0, 1, 0); PG8_SCHED; PG8_LDA(At, 1, 0); PG8_STAGE(PG8_SA(0, 1), a2 + hstep, voffA);
            PG8_WAIT_L(8); PG8_BAR; PG8_WAIT_L(0); PG8_MMA(0, 0, At, B0); PG8_BAR; PG8_SCHED;
            PG8_LDB(B1, 1, 1); PG8_STAGE(PG8_SB(1, 0), b3, voffB);
            PG8_BAR; PG8_WAIT_L(0); PG8_MMA(0, 1, At, B1); PG8_BAR;
            PG8_LDA(At, 1, 1); PG8_STAGE(PG8_SA(1, 0), a3, voffA);
            PG8_BAR; PG8_WAIT_L(0); PG8_MMA(1, 0, At, B0); PG8_BAR; PG8_SCHED;
            PG8_STAGE(PG8_SB(1, 1), b3 + hstep, voffB);
            PG8_WAIT_V(6); PG8_BAR; PG8_MMA(1, 1, At, B1); PG8_BAR;
        }
        const bool reset = E(acc, cur, wr, wc, fr, fq);
        if (!has_next) break;
        if (reset) {
#pragma unroll
            for (int a = 0; a < 2; ++a)
#pragma unroll
                for (int b = 0; b < 2; ++b)
#pragma unroll
                    for (int m = 0; m < 4; ++m)
#pragma unroll
                        for (int n = 0; n < 2; ++n) acc[a][b][m][n] = (f32x4){0.f, 0.f, 0.f, 0.f};
        }
        cur = nxt; cA = nA; cB = nB; ++ui;
    }
    PG8_WAIT_V(0);
    if (wr == 0) PG8_BAR;
    PG8_BAR;
#undef PG8_SA
#undef PG8_SB
#undef PG8_STAGE
#undef PG8_LDA
#undef PG8_LDB
#undef PG8_MMA
#undef PG8_WAIT_V
#undef PG8_WAIT_L
#undef PG8_BAR
#undef PG8_SCHED
}
}

__device__ __forceinline__ void tstore_pair(bf16_t* base  , size_t ld, float a, float b, int e0, bool odd) {
    const float send = odd ? a : b; const float recv = __shfl_xor(send, 1);
    const float lo = odd ? recv : a, hi = odd ? b : recv;
    *(unsigned*)(base + (size_t)(odd ? e0 + 1 : e0) * ld) = cvt_pk_bf16(lo, hi);
}

struct Epi1 {
    bf16_t *qb, *kb, *vT, *vTs, *ub, *gvbT, *sg; float* ssvb; float* out;
    __device__ __forceinline__ bool operator()(f32x4 (&acc)[2][2][4][2], const pg8::Unit& u, int wr, int wc, int fr, int fq) const {
        using namespace C;
        const int pn = u.pn; const int row0 = u.pm * 256 + wr * 64 + fr; const int cl = wc * 32 + 8 * fq;
        if (pn < 8) {
            bf16_t* dst = (pn < 4) ? qb : kb; const int cb = (pn & 3) * 256 + cl;
#pragma unroll
            for (int ai = 0; ai < 2; ++ai)
#pragma unroll
                for (int m = 0; m < 4; ++m) { const int row = row0 + ai * 128 + m * 16;
#pragma unroll
                    for (int bj = 0; bj < 2; ++bj) *(u32x4*)(dst + (size_t)row * 1024 + cb + bj * 128) = pack8u(acc[ai][bj][m][0], acc[ai][bj][m][1]); }
        } else if (pn < 12) {
            const bool odd = fr & 1; const int cb = (pn & 3) * 256 + cl;
#pragma unroll
            for (int ai = 0; ai < 2; ++ai)
#pragma unroll
                for (int m = 0; m < 4; ++m) { const int row = row0 + ai * 128 + m * 16; const int rowe = row & ~1;
                    bf16_t* base; size_t ld;
                    if (row < MP) { const int b = rowe >> 13, t = rowe & 8191; base = vT + (size_t)b * 1024 * 8192 + t; ld = 8192; }
                    else { const int rs = rowe - MP; base = vTs + (size_t)(rs >> 4) * 1024 * VTS_LD + 512 + (rs & 15); ld = VTS_LD; }
#pragma unroll
                    for (int bj = 0; bj < 2; ++bj)
#pragma unroll
                        for (int n = 0; n < 2; ++n)
#pragma unroll
                            for (int e = 0; e < 4; e += 2) tstore_pair(base + (size_t)(cb + bj * 128 + 4 * n) * ld, ld, acc[ai][bj][m][n][e], acc[ai][bj][m][n][e + 1], e, odd); }
        } else if (pn < 16) {
            const int cb = (pn & 3) * 256 + cl;
#pragma unroll
            for (int ai = 0; ai < 2; ++ai)
#pragma unroll
                for (int m = 0; m < 4; ++m) { const int row = row0 + ai * 128 + m * 16;
#pragma unroll
                    for (int bj = 0; bj < 2; ++bj) *(u32x4*)(ub + (size_t)row * 1024 + cb + bj * 128) = pack8u(gelu4(acc[ai][bj][m][0]), gelu4(acc[ai][bj][m][1])); }
        } else if (pn < 20) {
            const bool odd = fr & 1; const int cb = (pn & 3) * 256 + cl;
#pragma unroll
            for (int ai = 0; ai < 2; ++ai)
#pragma unroll
                for (int m = 0; m < 4; ++m) { const int row = row0 + ai * 128 + m * 16; const int rowe = row & ~1; float ss = 0.f;
#pragma unroll
                    for (int bj = 0; bj < 2; ++bj)
#pragma unroll
                        for (int n = 0; n < 2; ++n) { const f32x4 gv = gelu4(acc[ai][bj][m][n]); ss += dot4(gv);
#pragma unroll
                            for (int e = 0; e < 4; e += 2) tstore_pair(gvbT + (size_t)(cb + bj * 128 + 4 * n) * MPAD + rowe, MPAD, gv[e], gv[e + 1], e, odd); }
                    ss += __shfl_xor(ss, 16); ss += __shfl_xor(ss, 32);
                    if (fq == 0) atomicAdd(ssvb + row, ss); }
        } else {
            const int cb = (pn - 20) * 256 + cl;
#pragma unroll
            for (int ai = 0; ai < 2; ++ai)
#pragma unroll
                for (int m = 0; m < 4; ++m) { const int row = row0 + ai * 128 + m * 16;
#pragma unroll
                    for (int bj = 0; bj < 2; ++bj) *(u32x4*)(sg + (size_t)row * 4096 + cb + bj * 128) = pack8u(acc[ai][bj][m][0], acc[ai][bj][m][1]); }
        }
        if (pn >= 4 && pn < 12 && (u.pm >= 128 || (u.pm & 31) >= 30)) {
            const int cb = (pn & 3) * 256 + cl; const bool isv = pn >= 8;
#pragma unroll
            for (int ai = 0; ai < 2; ++ai)
#pragma unroll
                for (int m = 0; m < 4; ++m) { const int row = row0 + ai * 128 + m * 16; float* o;
                    if (row < MP) { const int b = row >> 13, t = row & 8191; o = out + (isv ? O_VP : O_KP) + ((size_t)(b * 512 + (t - 7680))) * 1024 + cb; }
                    else o = out + (isv ? O_VS : O_KS) + (size_t)(row - MP) * 1024 + cb;
#pragma unroll
                    for (int bj = 0; bj < 2; ++bj) { *(f32x4*)(o + bj * 128) = acc[ai][bj][m][0]; *(f32x4*)(o + bj * 128 + 4) = acc[ai][bj][m][1]; } }
        }
        return true;
    }
};

struct Epi2 {
    const bf16_t* sg; bf16_t* mb;
    __device__ __forceinline__ bool operator()(f32x4 (&acc)[2][2][4][2], const pg8::Unit& u, int wr, int wc, int fr, int fq) const {
        const int row0 = u.pm * 256 + wr * 64 + fr; const int cb = u.pn * 256 + wc * 32 + 8 * fq;
        if (u.sub == 0) {
#pragma unroll
            for (int ai = 0; ai < 2; ++ai)
#pragma unroll
                for (int m = 0; m < 4; ++m) { const int row = row0 + ai * 128 + m * 16;
#pragma unroll
                    for (int bj = 0; bj < 2; ++bj) { const u32x4 a = *(const u32x4*)(sg + (size_t)row * 4096 + cb + bj * 128), b = *(const u32x4*)(sg + (size_t)row * 4096 + 2048 + cb + bj * 128);
#pragma unroll
                        for (int w = 0; w < 4; ++w) { const float r0 = sigmoidf_(bf_lo(a[w])) * (1.0f + __builtin_amdgcn_exp2f(-1.4426950408889634f * bf_lo(b[w]))), r1 = sigmoidf_(bf_hi(a[w])) * (1.0f + __builtin_amdgcn_exp2f(-1.4426950408889634f * bf_hi(b[w])));
                            acc[ai][bj][m][w >> 1][(w & 1) * 2] *= r0; acc[ai][bj][m][w >> 1][(w & 1) * 2 + 1] *= r1; } }
                    asm volatile("" ::: "memory"); }
            return false;
        }
#pragma unroll
        for (int ai = 0; ai < 2; ++ai)
#pragma unroll
            for (int m = 0; m < 4; ++m) { const int row = row0 + ai * 128 + m * 16;
#pragma unroll
                for (int bj = 0; bj < 2; ++bj) { const u32x4 b = *(const u32x4*)(sg + (size_t)row * 4096 + 2048 + cb + bj * 128);
                    const f32x4 g0 = sigmoid4((f32x4){bf_lo(b[0]), bf_hi(b[0]), bf_lo(b[1]), bf_hi(b[1])}), g1 = sigmoid4((f32x4){bf_lo(b[2]), bf_hi(b[2]), bf_lo(b[3]), bf_hi(b[3])});
                    *(u32x4*)(mb + (size_t)row * 2048 + cb + bj * 128) = pack8u(acc[ai][bj][m][0] * g0, acc[ai][bj][m][1] * g1); }
                asm volatile("" ::: "memory"); }
        return true;
    }
};

struct Epi3 {
    const float *xp, *xs, *gffn; float* x1; bf16_t* x1g; float* ss2;
    __device__ __forceinline__ bool operator()(f32x4 (&acc)[2][2][4][2], const pg8::Unit& u, int wr, int wc, int fr, int fq) const {
        using namespace C;
        const int row0 = u.pm * 256 + wr * 64 + fr; const int cb = u.pn * 256 + wc * 32 + 8 * fq;
        f32x4 gv[2][2];
#pragma unroll
        for (int bj = 0; bj < 2; ++bj) { gv[bj][0] = *(const f32x4*)(gffn + cb + bj * 128); gv[bj][1] = *(const f32x4*)(gffn + cb + bj * 128 + 4); }
#pragma unroll
        for (int ai = 0; ai < 2; ++ai)
#pragma unroll
            for (int m = 0; m < 4; ++m) { const int row = row0 + ai * 128 + m * 16; const float* xr = (row < MP ? xp + (size_t)row * 2048 : xs + (size_t)(row - MP) * 2048) + cb; float ss = 0.f;
#pragma unroll
                for (int bj = 0; bj < 2; ++bj) { const f32x4 v0 = acc[ai][bj][m][0] + *(const f32x4*)(xr + bj * 128), v1 = acc[ai][bj][m][1] + *(const f32x4*)(xr + bj * 128 + 4);
                    float* o = x1 + (size_t)row * 2048 + cb + bj * 128; *(f32x4*)o = v0; *(f32x4*)(o + 4) = v1; ss += dot4(v0) + dot4(v1);
                    *(u32x4*)(x1g + (size_t)row * 2048 + cb + bj * 128) = pack8u(v0 * gv[bj][0], v1 * gv[bj][1]); }
                ss += __shfl_xor(ss, 16); ss += __shfl_xor(ss, 32);
                if (fq == 0) atomicAdd(ss2 + row, ss); }
        return true;
    }
};

struct Epi4 {
    const float* ss2; bf16_t* hb; float* out; int row_lo;
    __device__ __forceinline__ bool operator()(f32x4 (&acc)[2][2][4][2], const pg8::Unit& u, int wr, int wc, int fr, int fq) const {
        using namespace C;
        const int row0 = u.pm * 256 + wr * 64 + fr; const int cb = u.pn * 256 + wc * 32 + 8 * fq;
#pragma unroll
        for (int ai = 0; ai < 2; ++ai)
#pragma unroll
            for (int m = 0; m < 4; ++m) { const int row = row0 + ai * 128 + m * 16; const float inv = __builtin_amdgcn_rsqf(ss2[row] * (1.0f / 2048.0f) + EPS);
                float* o = nullptr;
                if (row < MP) { if ((row & 8191) >= 8190) o = out + O_CP + (size_t)((row >> 13) * 2 + (row & 8191) - 8190) * DFF2 + cb; }
                else if ((row & 15) >= 14) o = out + O_CS + (size_t)(((row - MP) >> 4) * 2 + (row & 15) - 14) * DFF2 + cb;
#pragma unroll
                for (int bj = 0; bj < 2; ++bj) { const f32x4 v0 = acc[ai][bj][m][0] * inv, v1 = acc[ai][bj][m][1] * inv;
                    __builtin_nontemporal_store(pack8u(v0, v1), (u32x4*)(hb + (size_t)(row - row_lo) * DFF2 + cb + bj * 128));
                    if (o) { *(f32x4*)(o + bj * 128) = v0; *(f32x4*)(o + bj * 128 + 4) = v1; } } }
        return true;
    }
};

struct Epi5 {
    float* x1; float* ss3;
    __device__ __forceinline__ bool operator()(f32x4 (&acc)[2][2][4][2], const pg8::Unit& u, int wr, int wc, int fr, int fq) const {
        const int row0 = u.pm * 256 + wr * 64 + fr; const int cb = u.pn * 256 + wc * 32 + 8 * fq;
#pragma unroll
        for (int ai = 0; ai < 2; ++ai)
#pragma unroll
            for (int m = 0; m < 4; ++m) { const int row = row0 + ai * 128 + m * 16; float ss = 0.f;
#pragma unroll
                for (int bj = 0; bj < 2; ++bj) { float* o = x1 + (size_t)row * 2048 + cb + bj * 128;
                    const f32x4 v0 = acc[ai][bj][m][0] + *(const f32x4*)o, v1 = acc[ai][bj][m][1] + *(const f32x4*)(o + 4);
                    *(f32x4*)o = v0; *(f32x4*)(o + 4) = v1; ss += dot4(v0) + dot4(v1); }
                ss += __shfl_xor(ss, 16); ss += __shfl_xor(ss, 32);
                if (fq == 0) atomicAdd(ss3 + row, ss); }
        return true;
    }
};

struct Epi5s {
    float* x1;
    __device__ __forceinline__ bool operator()(f32x4 (&acc)[2][2][4][2], const pg8::Unit& u, int wr, int wc, int fr, int fq) const {
        const int row0 = u.pm * 256 + wr * 64 + fr; const int cb = u.pn * 256 + wc * 32 + 8 * fq;
#pragma unroll
        for (int ai = 0; ai < 2; ++ai)
#pragma unroll
            for (int m = 0; m < 4; ++m) { const int row = row0 + ai * 128 + m * 16;
#pragma unroll
                for (int bj = 0; bj < 2; ++bj) { float* o = x1 + (size_t)row * 2048 + cb + bj * 128;
#pragma unroll
                    for (int n = 0; n < 2; ++n)
#pragma unroll
                        for (int e = 0; e < 4; ++e) atomicAdd(o + 4 * n + e, acc[ai][bj][m][n][e]); } }
        return true;
    }
};

__device__ __forceinline__ void transpose_tile(const float* in, int ldi, bf16_t* out, int ldo, int r0, int c0, float* tile) {
    const int tid = threadIdx.x;
#pragma unroll
    for (int i = 0; i < 8; ++i) { const int r = (tid >> 6) + 8 * i, c = tid & 63; tile[r * 65 + c] = in[(size_t)(r0 + r) * ldi + c0 + c]; }
    __syncthreads();
    { const int c = tid >> 3, ro = (tid & 7) * 8; float v[8];
#pragma unroll
      for (int e = 0; e < 8; ++e) v[e] = tile[(ro + e) * 65 + c];
      u32x4 w = {cvt_pk_bf16(v[0], v[1]), cvt_pk_bf16(v[2], v[3]), cvt_pk_bf16(v[4], v[5]), cvt_pk_bf16(v[6], v[7])};
      *(u32x4*)(out + (size_t)(c0 + c) * ldo + r0 + ro) = w; }
    __syncthreads();
}

namespace tt { constexpr int T_IN = 32 * 144, T_A = 16 * 32, T_B = 16 * 32, T_O = 32 * 32, T_UP = 32 * 176, T_D = 88 * 32, T_CV = 32 * 8 * 16;
               constexpr int E0 = T_IN, E1 = E0 + T_A, E2 = E1 + T_B, E3 = E2 + T_O, E4 = E3 + T_UP, E5 = E4 + T_D, E6 = E5 + T_CV; }
__device__ __forceinline__ void transpose_range(const Ptrs& P, float* tile, int t_begin, int t_end, int nblk, int bidx) {
    using namespace C; using namespace tt;
    unsigned char* ws = P.ws;
    for (int t = t_begin + bidx; t < t_end; t += nblk) {
        if (t < E0)      { const int q = t;      transpose_tile(P.w_in, DIN, (bf16_t*)(ws + W_WIN), 2048, (q % 32) * 64, (q / 32) * 64, tile); }
        else if (t < E1) { const int q = t - E0; transpose_tile(P.w_a, 2048, (bf16_t*)(ws + W_WA), 1024, (q % 16) * 64, (q / 16) * 64, tile); }
        else if (t < E2) { const int q = t - E1; transpose_tile(P.w_b, 2048, (bf16_t*)(ws + W_WB), 1024, (q % 16) * 64, (q / 16) * 64, tile); }
        else if (t < E3) { const int q = t - E2; transpose_tile(P.w_out, 2048, (bf16_t*)(ws + W_WO), 2048, (q % 32) * 64, (q / 32) * 64, tile); }
        else if (t < E4) { const int q = t - E3; transpose_tile(P.w_up, DFF2, (bf16_t*)(ws + W_WUP), 2048, (q % 32) * 64, (q / 32) * 64, tile); }
        else if (t < E5) { const int q = t - E4; transpose_tile(P.w_down, 2048, (bf16_t*)(ws + W_WD), DFF, (q % 88) * 64, (q / 88) * 64, tile); }
        else             { const int q = t - E5; const int b = q >> 7, r = q & 127; transpose_tile(P.cache_v + (size_t)b * 512 * 1024, 1024, (bf16_t*)(ws + W_VTS) + (size_t)b * 1024 * VTS_LD, VTS_LD, (r & 7) * 64, (r >> 3) * 64, tile); }
    }
}

__device__ __forceinline__ void phase0(const Ptrs& P, float* tile) {
    using namespace C;
    unsigned char* ws = P.ws;
    const int tid = threadIdx.x, lane = tid & 63, wid = tid >> 6, G = gridDim.x;
    { const size_t gt = (size_t)blockIdx.x * 512 + tid, gn = (size_t)G * 512;
      float* ss = (float*)(ws + W_SS1);
      for (size_t i = gt; i < (size_t)(W_WSB / 4); i += gn) ss[i] = 0.f;
      bf16_t* gvbT = (bf16_t*)(ws + W_GVBT);
      for (size_t i = gt; i < (size_t)1024 * 64; i += gn) gvbT[(i >> 6) * MPAD + M + (i & 63)] = 0;
      bf16_t* vTs = (bf16_t*)(ws + W_VTS);
      for (size_t i = gt; i < (size_t)32 * 1024 * 16; i += gn) vTs[(i >> 4) * VTS_LD + 528 + (i & 15)] = 0;
      bf16_t* wsb = (bf16_t*)(ws + W_WSB);
      for (size_t i = gt; i < (size_t)8 * 128 * 128; i += gn) { const int ii = (int)((i >> 7) & 127), jj = (int)(i & 127); const float v = jj <= ii ? P.w_s[i] : 0.f; wsb[i] = (bf16_t)(cvt_pk_bf16(v, 0.f) & 0xffffu); } }
    { bf16_t* xn = (bf16_t*)(ws + W_XN);
      for (int row = blockIdx.x * 8 + wid; row < M; row += G * 8) {
          const float* x = row < MP ? P.x_prompt + (size_t)row * 2048 : P.x_sample + (size_t)(row - MP) * 2048;
          f32x4 v[8]; float ss = 0.f;
#pragma unroll
          for (int i = 0; i < 4; ++i) { v[2 * i] = *(const f32x4*)(x + i * 512 + lane * 8); v[2 * i + 1] = *(const f32x4*)(x + i * 512 + lane * 8 + 4); ss += dot4(v[2 * i]) + dot4(v[2 * i + 1]); }
#pragma unroll
          for (int o = 32; o >= 1; o >>= 1) ss += __shfl_xor(ss, o);
          const float inv = __builtin_amdgcn_rsqf(ss * (1.0f / 2048.0f) + EPS);
#pragma unroll
          for (int i = 0; i < 4; ++i) { const f32x4 g0 = *(const f32x4*)(P.norm_mix_g + i * 512 + lane * 8), g1 = *(const f32x4*)(P.norm_mix_g + i * 512 + lane * 8 + 4);
              *(u32x4*)(xn + (size_t)row * 2048 + i * 512 + lane * 8) = pack8u(v[2 * i] * inv * g0, v[2 * i + 1] * inv * g1); }
      } }
    transpose_range(P, tile, 0, tt::E0, G, blockIdx.x); transpose_range(P, tile, tt::E5, tt::E6, G, blockIdx.x);
}

constexpr float ATT_C = 0.08838834764831845f * 1.4426950408889634f;

__device__ __forceinline__ void attn_softmax_pv(const f32x4 s0, const f32x4 s1, const LAS float* relb, int d0, bool valid, float& mrun, float& lrun, f32x4 (&o)[8], const bf16x8 (&vf)[8], int fq) {
    float t[8];
#pragma unroll
    for (int j = 0; j < 4; ++j) { int i0 = d0 - j; i0 = (i0 > 256 ? 256 : i0) + 256; int i1 = d0 - 4 - j; i1 = (i1 > 256 ? 256 : i1) + 256;
        t[j] = s0[j] * ATT_C + relb[i0]; t[4 + j] = s1[j] * ATT_C + relb[i1]; }
    if (!valid) {
#pragma unroll
        for (int j = 0; j < 8; ++j) t[j] = -__builtin_inff();
    }
    float tm = fmaxf(fmaxf(fmaxf(t[0], t[1]), fmaxf(t[2], t[3])), fmaxf(fmaxf(t[4], t[5]), fmaxf(t[6], t[7])));
    tm = fmaxf(tm, __shfl_xor(tm, 16)); tm = fmaxf(tm, __shfl_xor(tm, 32));
    const float mn = fmaxf(mrun, tm); const float alpha = __builtin_amdgcn_exp2f(mrun - mn); mrun = mn;
    float ps = 0.f;
#pragma unroll
    for (int j = 0; j < 8; ++j) { t[j] = __builtin_amdgcn_exp2f(t[j] - mn); ps += t[j]; }
    lrun = lrun * alpha + ps;
    float al[4];
#pragma unroll
    for (int jj = 0; jj < 4; ++jj) al[jj] = __shfl(alpha, 4 * fq + jj);
#pragma unroll
    for (int dt = 0; dt < 8; ++dt)
#pragma unroll
        for (int jj = 0; jj < 4; ++jj) o[dt][jj] *= al[jj];
    u32x4 pw = {cvt_pk_bf16(t[0], t[1]), cvt_pk_bf16(t[2], t[3]), cvt_pk_bf16(t[4], t[5]), cvt_pk_bf16(t[6], t[7])};
    const bf16x8 pf = *reinterpret_cast<bf16x8*>(&pw);
#pragma unroll
    for (int dt = 0; dt < 8; ++dt) o[dt] = mfma16(pf, vf[dt], o[dt]);
}
__device__ __forceinline__ void attn_store(bf16_t* ab  , float lrun, const f32x4 (&o)[8], int fr, int fq) {
    float l = lrun; l += __shfl_xor(l, 16); l += __shfl_xor(l, 32);
    const float linv = 1.0f / l;
#pragma unroll
    for (int jj = 0; jj < 4; ++jj) { const float li = __shfl(linv, 4 * fq + jj);
#pragma unroll
        for (int dt = 0; dt < 8; ++dt) { const float v = o[dt][jj] * li; const float vn = __shfl_xor(v, 1);
            if ((fr & 1) == 0) *(unsigned*)(ab + (size_t)(4 * fq + jj) * 1024 + dt * 16 + fr) = cvt_pk_bf16(v, vn); } }
}

__device__ __forceinline__ void attn_prompt_wave(const bf16_t* kb, const bf16_t* vT, bf16_t* qb, const LAS float* relb, int b, int h, int c, int sub, int lane) {
    const int fr = lane & 15, fq = lane >> 4;
    const int qpos0 = c * 64 + sub * 16;
    bf16_t* qrow = qb + ((size_t)b * 8192 + qpos0) * 1024 + h * 128;
    bf16x8 qf[4];
#pragma unroll
    for (int kk = 0; kk < 4; ++kk) qf[kk] = *(const bf16x8*)(qrow + (size_t)fr * 1024 + kk * 32 + fq * 8);
    int kt0 = (c - 8) * 2; if (kt0 < 0) kt0 = 0; const int kt1 = c * 2 + 2;
    const bf16_t* kp = kb + ((size_t)b * 8192 + 8 * (fr >> 2) + (fr & 3)) * 1024 + h * 128 + fq * 8;
    const bf16_t* vp = vT + ((size_t)(b * 1024 + h * 128 + fr)) * 8192 + 8 * fq;
    float mrun = -1e30f, lrun = 0.f; f32x4 o[8];
#pragma unroll
    for (int dt = 0; dt < 8; ++dt) o[dt] = (f32x4){0.f, 0.f, 0.f, 0.f};
    bf16x8 ka[8];
#pragma unroll
    for (int kk = 0; kk < 4; ++kk) { ka[kk] = *(const bf16x8*)(kp + (size_t)kt0 * 32 * 1024 + kk * 32); ka[4 + kk] = *(const bf16x8*)(kp + (size_t)(kt0 * 32 + 4) * 1024 + kk * 32); }
    for (int kt = kt0; kt < kt1; ++kt) {
        bf16x8 vf[8];
#pragma unroll
        for (int dt = 0; dt < 8; ++dt) vf[dt] = *(const bf16x8*)(vp + (size_t)dt * 16 * 8192 + kt * 32);
        f32x4 s0 = {0.f, 0.f, 0.f, 0.f}, s1 = {0.f, 0.f, 0.f, 0.f};
#pragma unroll
        for (int kk = 0; kk < 4; ++kk) { s0 = mfma16(ka[kk], qf[kk], s0); s1 = mfma16(ka[4 + kk], qf[kk], s1); }
        if (kt + 1 < kt1) {
#pragma unroll
            for (int kk = 0; kk < 4; ++kk) { ka[kk] = *(const bf16x8*)(kp + (size_t)(kt + 1) * 32 * 1024 + kk * 32); ka[4 + kk] = *(const bf16x8*)(kp + (size_t)((kt + 1) * 32 + 4) * 1024 + kk * 32); }
        }
        attn_softmax_pv(s0, s1, relb, (qpos0 + fr) - (kt * 32 + 8 * fq), true, mrun, lrun, o, vf, fq);
    }
    attn_store(qrow, lrun, o, fr, fq);
}


constexpr int ATT_KPITCH = 272, ATT_VPITCH = 144, ATT_KBYTES = 64 * ATT_KPITCH, ATT_VBYTES = 128 * ATT_VPITCH, ATT_STAGE = ATT_KBYTES + ATT_VBYTES, ATT_LDS_OFF = 16896;
__device__ __forceinline__ void attn_prompt_pair(const bf16_t* kb, const bf16_t* vT, bf16_t* qb, LAS unsigned char* stg, const LAS float* relb, int b, int h, int cp, int wid, int lane, int tid) {
    const int fr = lane & 15, fq = lane >> 4, half = wid >> 2, c = 2 * cp + half;
    const int qpos0 = c * 64 + (wid & 3) * 16;
    bf16_t* qrow = qb + ((size_t)b * 8192 + qpos0) * 1024 + h * 128;
    bf16x8 qf[4];
#pragma unroll
    for (int kk = 0; kk < 4; ++kk) qf[kk] = *(const bf16x8*)(qrow + (size_t)fr * 1024 + kk * 32 + fq * 8);
    int s_lo = 2 * cp - 8; if (s_lo < 0) s_lo = 0; const int s_hi = 2 * cp + 2;
    const bf16_t* kg = kb + ((size_t)b * 8192 + (tid >> 4)) * 1024 + h * 128 + (tid & 15) * 8;
    const bf16_t* vg = vT + ((size_t)(b * 1024 + h * 128 + (tid >> 2))) * 8192 + (tid & 3) * 16;
    const int k32 = tid >> 4;
    const int kw0 = ((((k32 >> 2) & 1) * 16) + (((k32 >> 3) << 2) | (k32 & 3))) * ATT_KPITCH + (tid & 15) * 16, kw1 = kw0 + 32 * ATT_KPITCH;
    const int vw0 = ATT_KBYTES + (tid >> 2) * ATT_VPITCH + (tid & 3) * 32, vw1 = vw0 + 16;
    const int kr0 = fr * ATT_KPITCH + fq * 16, vr0 = ATT_KBYTES + fr * ATT_VPITCH + fq * 16;
    float mrun = -1e30f, lrun = 0.f; f32x4 o[8];
#pragma unroll
    for (int dt = 0; dt < 8; ++dt) o[dt] = (f32x4){0.f, 0.f, 0.f, 0.f};
    u32x4 st0, st1, st2, st3;
#define ATT_LOAD(s) do { st0 = *(const u32x4*)(kg + (size_t)(s) * 64 * 1024); st1 = *(const u32x4*)(kg + (size_t)((s) * 64 + 32) * 1024); st2 = *(const u32x4*)(vg + (s) * 64); st3 = *(const u32x4*)(vg + (s) * 64 + 8); } while (0)
#define ATT_WRITE(bf) do { LAS unsigned char* w_ = stg + (bf) * ATT_STAGE; *(LAS u32x4*)(w_ + kw0) = st0; *(LAS u32x4*)(w_ + kw1) = st1; *(LAS u32x4*)(w_ + vw0) = st2; *(LAS u32x4*)(w_ + vw1) = st3; } while (0)
    ATT_LOAD(s_lo); ATT_WRITE(0);
    __syncthreads();
    for (int s = s_lo; s < s_hi; ++s) {
        const int cur = (s - s_lo) & 1;
        if (s + 1 < s_hi) ATT_LOAD(s + 1);
        const bool act = half == 0 ? (s <= 2 * cp) : (s >= 2 * cp - 7);
        if (act) {
            const LAS unsigned char* rb = stg + cur * ATT_STAGE;
#pragma unroll
            for (int j = 0; j < 2; ++j) {
                bf16x8 ka[8], vf[8];
#pragma unroll
                for (int kk = 0; kk < 4; ++kk) { ka[kk] = *(const LAS bf16x8*)(rb + kr0 + j * 32 * ATT_KPITCH + kk * 64); ka[4 + kk] = *(const LAS bf16x8*)(rb + kr0 + (j * 32 + 16) * ATT_KPITCH + kk * 64); }
#pragma unroll
                for (int dt = 0; dt < 8; ++dt) vf[dt] = *(const LAS bf16x8*)(rb + vr0 + dt * 16 * ATT_VPITCH + j * 64);
                f32x4 s0 = {0.f, 0.f, 0.f, 0.f}, s1 = {0.f, 0.f, 0.f, 0.f};
#pragma unroll
                for (int kk = 0; kk < 4; ++kk) { s0 = mfma16(ka[kk], qf[kk], s0); s1 = mfma16(ka[4 + kk], qf[kk], s1); }
                attn_softmax_pv(s0, s1, relb, (qpos0 + fr) - ((2 * s + j) * 32 + 8 * fq), true, mrun, lrun, o, vf, fq);
            }
        }
        if (s + 1 < s_hi) ATT_WRITE(cur ^ 1);
        __syncthreads();
    }
#undef ATT_LOAD
#undef ATT_WRITE
    attn_store(qrow, lrun, o, fr, fq);
}

__device__ __forceinline__ void attn_sample_wave(const float* cache_k, const bf16_t* kb, const bf16_t* vTs, bf16_t* qb, const LAS float* relb, int bs, int h, int lane) {
    using namespace C;
    const int fr = lane & 15, fq = lane >> 4;
    bf16_t* qrow = qb + ((size_t)MP + bs * 16) * 1024 + h * 128;
    bf16x8 qf[4];
#pragma unroll
    for (int kk = 0; kk < 4; ++kk) qf[kk] = *(const bf16x8*)(qrow + (size_t)fr * 1024 + kk * 32 + fq * 8);
    const int krow = 8 * (fr >> 2) + (fr & 3);
    const float* ckp = cache_k + ((size_t)bs * 512 + krow) * 1024 + h * 128 + fq * 8;
    const bf16_t* nkp = kb + ((size_t)MP + bs * 16) * 1024 + h * 128 + fq * 8;
    const bf16_t* vp = vTs + ((size_t)(bs * 1024 + h * 128 + fr)) * VTS_LD + 8 * fq;
    float mrun = -1e30f, lrun = 0.f; f32x4 o[8];
#pragma unroll
    for (int dt = 0; dt < 8; ++dt) o[dt] = (f32x4){0.f, 0.f, 0.f, 0.f};
    for (int kt = 0; kt < 17; ++kt) {
        bf16x8 vf[8];
#pragma unroll
        for (int dt = 0; dt < 8; ++dt) vf[dt] = *(const bf16x8*)(vp + (size_t)dt * 16 * VTS_LD + kt * 32);
        bf16x8 ka[8];
        if (kt < 16) {
#pragma unroll
            for (int kk = 0; kk < 4; ++kk) { const float* p0 = ckp + (size_t)kt * 32 * 1024 + kk * 32; const float* p1 = p0 + 4 * 1024;
                ka[kk] = pack8(*(const f32x4*)p0, *(const f32x4*)(p0 + 4)); ka[4 + kk] = pack8(*(const f32x4*)p1, *(const f32x4*)(p1 + 4)); }
        } else {
#pragma unroll
            for (int kk = 0; kk < 4; ++kk) { ka[kk] = *(const bf16x8*)(nkp + (size_t)(krow & 15) * 1024 + kk * 32); ka[4 + kk] = *(const bf16x8*)(nkp + (size_t)((krow + 4) & 15) * 1024 + kk * 32); }
        }
        f32x4 s0 = {0.f, 0.f, 0.f, 0.f}, s1 = {0.f, 0.f, 0.f, 0.f};
#pragma unroll
        for (int kk = 0; kk < 4; ++kk) { s0 = mfma16(ka[kk], qf[kk], s0); s1 = mfma16(ka[4 + kk], qf[kk], s1); }
        attn_softmax_pv(s0, s1, relb, (512 + fr) - (kt * 32 + 8 * fq), kt < 16 || fq < 2, mrun, lrun, o, vf, fq);
    }
    attn_store(qrow, lrun, o, fr, fq);
}

template <bool SAMPLE>
__device__ __forceinline__ void sgu_wave(const Ptrs& P, int r0, int g, int bs, int lane) {
    using namespace C;
    constexpr int NJC = SAMPLE ? 1 : 4, NIT = SAMPLE ? 1 : 8;
    const unsigned char* ws = P.ws;
    const float* ssvb = (const float*)(ws + W_SS1); const bf16_t* gvbT = (const bf16_t*)(ws + W_GVBT); const bf16_t* wsb = (const bf16_t*)(ws + W_WSB);
    const bf16_t* ub = (const bf16_t*)(ws + W_UB); bf16_t* sb = (bf16_t*)(P.ws + W_SB);
    const int fr = lane & 15, fq = lane >> 4;
    float inv[NJC][8];
#pragma unroll
    for (int jc = 0; jc < NJC; ++jc) { const f32x4 a = *(const f32x4*)(ssvb + r0 + jc * 32 + 8 * fq), b = *(const f32x4*)(ssvb + r0 + jc * 32 + 8 * fq + 4);
#pragma unroll
        for (int e = 0; e < 4; ++e) { inv[jc][e] = __builtin_amdgcn_rsqf(a[e] * (1.0f / 1024.0f) + EPS); inv[jc][4 + e] = __builtin_amdgcn_rsqf(b[e] * (1.0f / 1024.0f) + EPS); } }
    bf16x8 wf[NIT][NJC]; float bsv[NIT];
#pragma unroll
    for (int it = 0; it < NIT; ++it) { bsv[it] = P.b_s[g * 128 + it * 16 + fr];
#pragma unroll
        for (int jc = 0; jc < NJC; ++jc) if (jc <= (it >> 1)) wf[it][jc] = *(const bf16x8*)(wsb + (size_t)(g * 128 + it * 16 + fr) * 128 + jc * 32 + 8 * fq); }
    for (int dt = 0; dt < 8; ++dt) {
        const int col = g * 128 + dt * 16 + fr;
        const int cb = g * 128 + dt * 16 + 4 * fq;
        u32x4 raw[NJC]; u32x2 uu[NIT];
#pragma unroll
        for (int jc = 0; jc < NJC; ++jc) raw[jc] = *(const u32x4*)(gvbT + (size_t)col * MPAD + r0 + jc * 32 + 8 * fq);
#pragma unroll
        for (int it = 0; it < NIT; ++it) uu[it] = *(const u32x2*)(ub + (size_t)(r0 + it * 16 + fr) * 1024 + cb);
        const f32x4 gain = *(const f32x4*)(P.sgu_norm_g + cb);
        bf16x8 xf[NJC];
#pragma unroll
        for (int jc = 0; jc < NJC; ++jc) {
            float x[8];
#pragma unroll
            for (int w = 0; w < 4; ++w) { x[2 * w] = bf_lo(raw[jc][w]) * inv[jc][2 * w]; x[2 * w + 1] = bf_hi(raw[jc][w]) * inv[jc][2 * w + 1]; }
            u32x4 pw = {cvt_pk_bf16(x[0], x[1]), cvt_pk_bf16(x[2], x[3]), cvt_pk_bf16(x[4], x[5]), cvt_pk_bf16(x[6], x[7])};
            xf[jc] = *reinterpret_cast<bf16x8*>(&pw);
            if (SAMPLE) { if (fq < 2) { const float gn = P.sgu_norm_g[col];
#pragma unroll
                for (int e = 0; e < 8; ++e) P.out[O_SGU + (size_t)(bs * 16 + 8 * fq + e) * 1024 + col] = x[e] * gn; } } }
#pragma unroll
        for (int it = 0; it < NIT; ++it) {
            f32x4 acc = {0.f, 0.f, 0.f, 0.f};
#pragma unroll
            for (int jc = 0; jc < NJC; ++jc) if (jc <= (it >> 1)) acc = mfma16(xf[jc], wf[it][jc], acc);
            const int row = r0 + it * 16 + fr;
            const float s0 = bf_lo(uu[it][0]) * (acc[0] * gain[0] + bsv[it]), s1 = bf_hi(uu[it][0]) * (acc[1] * gain[1] + bsv[it]), s2 = bf_lo(uu[it][1]) * (acc[2] * gain[2] + bsv[it]), s3 = bf_hi(uu[it][1]) * (acc[3] * gain[3] + bsv[it]);
            u32x2 sw = {cvt_pk_bf16(s0, s1), cvt_pk_bf16(s2, s3)};
            *(u32x2*)(sb + (size_t)row * 1024 + cb) = sw;
        }
    }
}

__device__ __forceinline__ void phase2(const Ptrs& P, LAS float* relb) {
    using namespace C;
    const int tid = threadIdx.x, lane = tid & 63, wid = __builtin_amdgcn_readfirstlane(tid >> 6), G = gridDim.x;
    for (int i = tid; i < 8 * 513; i += 512) relb[(i / 513) * 520 + (i % 513)] = P.rel_bias[i] * 1.4426950408889634f;
    __syncthreads();
    bf16_t* qb = (bf16_t*)(P.ws + W_QB); const bf16_t* kb = (const bf16_t*)(P.ws + W_KB); const bf16_t* vT = (const bf16_t*)(P.ws + W_VT); const bf16_t* vTs = (const bf16_t*)(P.ws + W_VTS);
    constexpr int N_AP = 4 * 8 * 64, N_SGU = 256, N_SGUS = 32, N_AS = 32, N_TOT = N_AP + N_SGU + N_SGUS + N_AS;
    for (int it = blockIdx.x; it < N_TOT; it += G) {
        if (it < N_AP) {
            const int cp = it & 63, h = (it >> 6) & 7, b = it >> 9;
            attn_prompt_pair(kb, vT, qb, (LAS unsigned char*)relb + ATT_LDS_OFF, relb + h * 520, b, h, cp, wid, lane, tid);
        } else if (it < N_AP + N_SGU) {
            const int q = it - N_AP; sgu_wave<false>(P, q * 128, wid, 0, lane);
        } else if (it < N_AP + N_SGU + N_SGUS) {
            const int bs = it - N_AP - N_SGU; sgu_wave<true>(P, MP + bs * 16, wid, bs, lane);
        } else {
            const int bs = it - N_AP - N_SGU - N_SGUS; attn_sample_wave(P.cache_k, kb, vTs, qb, relb + wid * 520, bs, wid, lane);
        }
    }
}

__device__ __forceinline__ void conv_phase(const Ptrs& P, int row_lo, int row_hi) {
    using namespace C;
    const int tid = threadIdx.x, lane = tid & 63, wid = tid >> 6, G = gridDim.x;
    const bf16_t* hb = (const bf16_t*)(P.ws + W_H); bf16_t* act = (bf16_t*)(P.ws + W_ACT);
    const int total = ((row_hi - row_lo) / 16) * 11;
    for (int wi = blockIdx.x * 8 + wid; wi < total; wi += G * 8) {
        const int chunk = wi / 11, slab = wi - chunk * 11; const int r0 = row_lo + chunk * 16; const int c = slab * 512 + lane * 8;
        float cw[2][3][8], cbv[2][8], h1[2][8], h2[2][8];
#pragma unroll
        for (int s = 0; s < 2; ++s) { const int cc = c + s * DFF;
#pragma unroll
            for (int k = 0; k < 3; ++k) { const f32x4 a = *(const f32x4*)(P.conv_w + (size_t)k * DFF2 + cc), b = *(const f32x4*)(P.conv_w + (size_t)k * DFF2 + cc + 4);
#pragma unroll
                for (int e = 0; e < 4; ++e) { cw[s][k][e] = a[e]; cw[s][k][4 + e] = b[e]; } }
            { const f32x4 a = *(const f32x4*)(P.conv_b + cc), b = *(const f32x4*)(P.conv_b + cc + 4);
#pragma unroll
              for (int e = 0; e < 4; ++e) { cbv[s][e] = a[e]; cbv[s][4 + e] = b[e]; } }
            if (r0 >= MP) { const float* p2 = P.cache_conv + (size_t)((r0 - MP) >> 4) * 2 * DFF2 + cc; const float* p1 = p2 + DFF2;
                const f32x4 a2 = *(const f32x4*)p2, b2 = *(const f32x4*)(p2 + 4), a1 = *(const f32x4*)p1, b1 = *(const f32x4*)(p1 + 4);
#pragma unroll
                for (int e = 0; e < 4; ++e) { h2[s][e] = a2[e]; h2[s][4 + e] = b2[e]; h1[s][e] = a1[e]; h1[s][4 + e] = b1[e]; } }
            else if ((r0 & 8191) == 0) {
#pragma unroll
                for (int e = 0; e < 8; ++e) { h2[s][e] = 0.f; h1[s][e] = 0.f; } }
            else { const u32x4 w2 = *(const u32x4*)(hb + (size_t)(r0 - 2 - row_lo) * DFF2 + cc), w1 = *(const u32x4*)(hb + (size_t)(r0 - 1 - row_lo) * DFF2 + cc);
#pragma unroll
                for (int w = 0; w < 4; ++w) { h2[s][2 * w] = bf_lo(w2[w]); h2[s][2 * w + 1] = bf_hi(w2[w]); h1[s][2 * w] = bf_lo(w1[w]); h1[s][2 * w + 1] = bf_hi(w1[w]); } }
        }
#pragma unroll 2
        for (int i = 0; i < 16; ++i) { const int row = r0 + i;
            float hc[2][8], y[2][8];
#pragma unroll
            for (int s = 0; s < 2; ++s) { const u32x4 w0 = __builtin_nontemporal_load((const u32x4*)(hb + (size_t)(row - row_lo) * DFF2 + c + s * DFF));
#pragma unroll
                for (int w = 0; w < 4; ++w) { hc[s][2 * w] = bf_lo(w0[w]); hc[s][2 * w + 1] = bf_hi(w0[w]); }
#pragma unroll
                for (int e = 0; e < 8; ++e) { y[s][e] = cbv[s][e] + cw[s][0][e] * h2[s][e] + cw[s][1][e] * h1[s][e] + cw[s][2][e] * hc[s][e]; h2[s][e] = h1[s][e]; h1[s][e] = hc[s][e]; } }
            f32x4 g0 = gelu4((f32x4){y[0][0], y[0][1], y[0][2], y[0][3]}), g1 = gelu4((f32x4){y[0][4], y[0][5], y[0][6], y[0][7]});
            const f32x4 v0 = {y[1][0], y[1][1], y[1][2], y[1][3]}, v1 = {y[1][4], y[1][5], y[1][6], y[1][7]};
            *(u32x4*)(act + (size_t)row * DFF + c) = pack8u(g0 * v0, g1 * v1);
        }
    }
}

__device__ __forceinline__ void final_phase(const Ptrs& P) {
    using namespace C;
    const int tid = threadIdx.x, lane = tid & 63, wid = tid >> 6, G = gridDim.x;
    const float* ss3 = (const float*)(P.ws + W_SS3);
    for (int row = blockIdx.x * 8 + wid; row < M; row += G * 8) {
        float* y = P.out + (size_t)row * 2048;
        f32x4 v[8];
#pragma unroll
        for (int i = 0; i < 8; ++i) v[i] = *(const f32x4*)(y + i * 256 + lane * 4);
        float ss;
        if (row >= MP) { ss = 0.f;
#pragma unroll
            for (int i = 0; i < 8; ++i) ss += dot4(v[i]);
#pragma unroll
            for (int o = 32; o >= 1; o >>= 1) ss += __shfl_xor(ss, o); }
        else ss = ss3[row];
        const float inv = __builtin_amdgcn_rsqf(ss * (1.0f / 2048.0f) + EPS);
#pragma unroll
        for (int i = 0; i < 8; ++i) { const int cc = i * 256 + lane * 4; *(f32x4*)(y + cc) = v[i] * inv * *(const f32x4*)(P.norm_final_g + cc); }
    }
}

#define XB_TMO      128
#define XB_XCNT(j)  (256  + 64 * (j))
#define XB_XSUB(j)  (1280 + 64 * (j))
#define XB_XGEN(j)  (2304 + 64 * (j))
#define XB_TOP      3328
#define XB_TOPGEN   3392
#define XCD_BAR_WORDS 3456
#define XB_SPIN_CAP (1u << 18)
constexpr size_t W_XBAR = 720896;
__device__ __forceinline__ unsigned xb_ld(unsigned* p)              { return __hip_atomic_load(p, __ATOMIC_RELAXED, __HIP_MEMORY_SCOPE_AGENT); }
__device__ __forceinline__ unsigned xb_add(unsigned* p, unsigned v) { return __hip_atomic_fetch_add(p, v, __ATOMIC_RELAXED, __HIP_MEMORY_SCOPE_AGENT); }
__device__ __forceinline__ unsigned xb_xcc_id() { return (unsigned)__builtin_amdgcn_s_getreg((3 << 11) | 20) & 0xFu; }
#define XB_SPIN(cond, bar) do { unsigned _sp = 0; while (cond) { __builtin_amdgcn_s_sleep(1); \
    if ((++_sp & 255u) == 0u) { if (xb_ld(&(bar)[XB_TMO])) break; if (_sp > XB_SPIN_CAP) { atomicAdd(&(bar)[XB_TMO], 1u); break; } } } } while (0)
struct XcdBarrier { unsigned* bar; unsigned x; volatile LAS unsigned* st; };
__device__ __forceinline__ XcdBarrier xcd_barrier_post(unsigned* bar, volatile LAS unsigned* st) {
    XcdBarrier b; b.bar = bar; b.x = xb_xcc_id(); b.st = st;
    if (threadIdx.x == 0) (void)xb_add(&bar[XB_XCNT(b.x)], 1u);
    return b;
}
__device__ __forceinline__ void xcd_barrier_complete(unsigned* bar, unsigned x, unsigned& nloc, unsigned& nx) {
    const unsigned G = gridDim.x * gridDim.y * gridDim.z;
    unsigned sum, cnt, mine, sp = 0u;
    for (;;) {
        sum = 0u; cnt = 0u; mine = 0u;
#pragma unroll
        for (unsigned j = 0; j < 16; ++j) { const unsigned c = xb_ld(&bar[XB_XCNT(j)]); sum += c; cnt += (c > 0u) ? 1u : 0u; mine = (j == x) ? c : mine; }
        if (sum == G) break;
        __builtin_amdgcn_s_sleep(1);
        if ((++sp & 255u) == 0u) { if (xb_ld(&bar[XB_TMO])) break; if (sp > XB_SPIN_CAP) { atomicAdd(&bar[XB_TMO], 1u); break; } }
    }
    nloc = mine > 0u ? mine : 1u; nx = cnt > 0u ? cnt : 1u;
}
__device__ __forceinline__ void xcd_barrier(const XcdBarrier& b) {
    asm volatile("s_waitcnt vmcnt(0)" ::: "memory");
    __syncthreads();
    if (threadIdx.x == 0) {
        unsigned* bar = b.bar;
        __builtin_amdgcn_s_waitcnt(0);
        unsigned nloc = b.st[0], nx = b.st[1];
        if (nloc == 0u) { xcd_barrier_complete(bar, b.x, nloc, nx); b.st[0] = nloc; b.st[1] = nx; }
        const unsigned old = xb_add(&bar[XB_XSUB(b.x)], 1u);
        const unsigned gen = old / nloc;
        if (old + 1u == (gen + 1u) * nloc) {
            __builtin_amdgcn_fence(__ATOMIC_RELEASE, "agent");
            asm volatile("s_waitcnt vmcnt(0)" ::: "memory");
            const unsigned og = xb_add(&bar[XB_TOP], 1u);
            const unsigned tg = og / nx;
            if (og + 1u == (tg + 1u) * nx) xb_add(&bar[XB_TOPGEN], 1u);
            else XB_SPIN(xb_ld(&bar[XB_TOPGEN]) == tg, bar);
            __builtin_amdgcn_fence(__ATOMIC_ACQUIRE, "agent");
            xb_add(&bar[XB_XGEN(b.x)], 1u);
            asm volatile("s_waitcnt vmcnt(0)" ::: "memory");
        } else {
            XB_SPIN(xb_ld(&bar[XB_XGEN(b.x)]) == gen, bar);
            __builtin_amdgcn_fence(__ATOMIC_ACQUIRE, "agent");
            asm volatile("s_waitcnt vmcnt(0)" ::: "memory");
        }
    }
    __syncthreads();
}

__global__ void __launch_bounds__(512) mega(Params prm) {
    extern __shared__ __attribute__((aligned(16))) unsigned char lds_raw[];
    using namespace C;
    Ptrs P;
    P.x_prompt = prm.in[0]; P.x_sample = prm.in[1]; P.cache_k = prm.in[2]; P.cache_v = prm.in[3]; P.cache_conv = prm.in[4]; P.norm_mix_g = prm.in[5]; P.w_in = prm.in[6]; P.rel_bias = prm.in[7];
    P.sgu_norm_g = prm.in[8]; P.w_s = prm.in[9]; P.b_s = prm.in[10]; P.w_a = prm.in[11]; P.w_b = prm.in[12]; P.w_out = prm.in[13]; P.norm_ffn_g = prm.in[14]; P.w_up = prm.in[15];
    P.conv_w = prm.in[16]; P.conv_b = prm.in[17]; P.w_down = prm.in[18]; P.norm_final_g = prm.in[19]; P.out = prm.out; P.ws = prm.ws;
    unsigned char* ws = prm.ws;
    LAS unsigned char* lds = (LAS unsigned char*)lds_raw;
    const int lo = prm.ph_lo, hi = prm.ph_hi, G = gridDim.x, bx = blockIdx.x;
#define IN(k) (lo <= (k) && (k) < hi)
    if (lo > 1000) cg::this_grid().sync();
    volatile LAS unsigned* const xst = (volatile LAS unsigned*)(lds + 131072);
    if (threadIdx.x < 4) xst[threadIdx.x] = 0u;
    __syncthreads();
    const XcdBarrier xbar = xcd_barrier_post((unsigned*)(ws + W_XBAR), xst);
#define SEAM(k) do { if (IN(k) && IN((k) + 1)) xcd_barrier(xbar); } while (0)

    if (IN(0)) phase0(P, (float*)lds_raw);
    SEAM(0);
    if (IN(1)) {
        const bf16_t* a = (const bf16_t*)(ws + W_XN); const bf16_t* w = (const bf16_t*)(ws + W_WIN); pg8::Gemm g{a, a, a, a, w, w, w, w, 2048, 2048}; pg8::Sched S{0, 130, 36, 1, G, bx};
        Epi1 E{(bf16_t*)(ws + W_QB), (bf16_t*)(ws + W_KB), (bf16_t*)(ws + W_VT), (bf16_t*)(ws + W_VTS), (bf16_t*)(ws + W_UB), (bf16_t*)(ws + W_GVBT), (bf16_t*)(ws + W_SG), (float*)(ws + W_SS1), P.out};
        pg8::gemm_phase(lds, g, S, E);
        if (bx >= 72) transpose_range(P, (float*)lds_raw, tt::E0, tt::E3, G - 72, bx - 72);
    }
    SEAM(1);
    if (IN(2)) phase2(P, (LAS float*)lds);
    SEAM(2);
    if (IN(3)) {
        const bf16_t *a0 = (const bf16_t*)(ws + W_QB), *a1 = (const bf16_t*)(ws + W_SB), *w0 = (const bf16_t*)(ws + W_WA), *w1 = (const bf16_t*)(ws + W_WB); pg8::Gemm g{a0, a1, a1, a1, w0, w1, w1, w1, 1024, 1024}; pg8::Sched S{0, 130, 8, 2, G, bx};
        Epi2 E{(const bf16_t*)(ws + W_SG), (bf16_t*)(ws + W_MB)};
        pg8::gemm_phase(lds, g, S, E);
        if (bx >= 16) transpose_range(P, (float*)lds_raw, tt::E3, tt::E4, G - 16, bx - 16);
    }
    SEAM(3);
    if (IN(4)) {
        const bf16_t* a = (const bf16_t*)(ws + W_MB); const bf16_t* w = (const bf16_t*)(ws + W_WO); pg8::Gemm g{a, a, a, a, w, w, w, w, 2048, 2048}; pg8::Sched S{0, 130, 8, 1, G, bx};
        Epi3 E{P.x_prompt, P.x_sample, P.norm_ffn_g, P.out, (bf16_t*)(ws + W_X1G), (float*)(ws + W_SS2)};
        pg8::gemm_phase(lds, g, S, E);
        if (bx >= 16) transpose_range(P, (float*)lds_raw, tt::E4, tt::E5, G - 16, bx - 16);
    }
    SEAM(4);
    if (IN(5)) {
        const bf16_t* a = (const bf16_t*)(ws + W_X1G); const bf16_t* w = (const bf16_t*)(ws + W_WUP); pg8::Gemm g{a, a, a, a, w, w, w, w, 2048, 2048}; pg8::Sched S{0, 64, 44, 1, G, bx};
        Epi4 E{(const float*)(ws + W_SS2), (bf16_t*)(ws + W_H), P.out, 0};
        pg8::gemm_phase(lds, g, S, E);
    }
    SEAM(5);
    if (IN(6)) conv_phase(P, 0, HALF_ROWS);
    SEAM(6);
    if (IN(7)) {
        const bf16_t* a = (const bf16_t*)(ws + W_X1G); const bf16_t* w = (const bf16_t*)(ws + W_WUP); pg8::Gemm g{a, a, a, a, w, w, w, w, 2048, 2048}; pg8::Sched S{64, 66, 44, 1, G, bx};
        Epi4 E{(const float*)(ws + W_SS2), (bf16_t*)(ws + W_H), P.out, HALF_ROWS};
        pg8::gemm_phase(lds, g, S, E);
    }
    SEAM(7);
    if (IN(8)) conv_phase(P, HALF_ROWS, M);
    SEAM(8);
    if (IN(9)) {
        const bf16_t* a = (const bf16_t*)(ws + W_ACT); const bf16_t* w = (const bf16_t*)(ws + W_WD);
        { pg8::Gemm g{a, a, a, a, w, w, w, w, 5632, 5632}; pg8::Sched S{0, 128, 8, 1, G, bx};
          Epi5 E{P.out, (float*)(ws + W_SS3)}; pg8::gemm_phase(lds, g, S, E); }
        { pg8::Gemm g{a, a + 1408, a + 2816, a + 4224, w, w + 1408, w + 2816, w + 4224, 1408, 5632}; pg8::SchedK4 S{G, bx};
          Epi5s E{P.out}; pg8::gemm_phase(lds, g, S, E); }
    }
    SEAM(9);
    if (IN(10)) final_phase(P);
#undef IN
#undef SEAM
}

constexpr int N_PHASES = 11;
constexpr int LDS_BYTES = pg8::STAGE_BYTES + 16;

extern "C" void kernel_launch(void* const* d_in, const int* in_sizes, int n_in, void* d_out, int out_size, void* d_ws, size_t ws_size, hipStream_t stream) {
    static int grid = 0;
    if (grid == 0) {
        int dev = 0, cus = 0, per_cu = 0;
        hipGetDevice(&dev);
        hipDeviceGetAttribute(&cus, hipDeviceAttributeMultiprocessorCount, dev);
        if (hipFuncSetAttribute((const void*)mega, hipFuncAttributeMaxDynamicSharedMemorySize, LDS_BYTES) != hipSuccess) { fprintf(stderr, "kernel_launch: hipFuncSetAttribute failed\n"); }
        if (hipOccupancyMaxActiveBlocksPerMultiprocessor(&per_cu, (const void*)mega, 512, LDS_BYTES) != hipSuccess || per_cu < 1) { fprintf(stderr, "kernel_launch: occupancy query says %d\n", per_cu); per_cu = 1; }
        (void)hipGetLastError();
        if (cus <= 0) cus = 256;
        grid = cus;
        if (n_in != 20 || ws_size < C::W_ACT + (size_t)C::M * C::DFF * 2) fprintf(stderr, "kernel_launch: unexpected n_in %d / ws_size %zu\n", n_in, ws_size);
    }
    Params p{};
    for (int i = 0; i < 20; ++i) p.in[i] = (const float*)d_in[i];
    p.out = (float*)d_out; p.ws = (unsigned char*)d_ws;
#if ONE_LAUNCH
    p.ph_lo = 0; p.ph_hi = N_PHASES;
    if (hipMemsetAsync((unsigned char*)d_ws + W_XBAR, 0, XCD_BAR_WORDS * 4, stream) != hipSuccess) fprintf(stderr, "kernel_launch: memset of the barrier words failed\n");
    void* args[] = {&p};
    hipError_t e = hipLaunchCooperativeKernel((const void*)mega, dim3(grid), dim3(512), args, LDS_BYTES, stream);
    if (e != hipSuccess) fprintf(stderr, "cooperative launch failed: %s (grid %d)\n", hipGetErrorString(e), grid);
#else
    for (int k = 0; k < N_PHASES; ++k) { p.ph_lo = k; p.ph_hi = k + 1; hipLaunchKernelGGL(mega, dim3(grid), dim3(512), LDS_BYTES, stream, p); }
#endif
}
```

```cpp
#include <hip/hip_runtime.h>
#include <hip/hip_cooperative_groups.h>
#include <cstdio>
namespace cg = cooperative_groups;

#ifndef ONE_LAUNCH
#define ONE_LAUNCH 1
#endif

#define LAS __attribute__((address_space(3)))
typedef unsigned short bf16_t;
typedef short bf16x8 __attribute__((ext_vector_type(8)));
typedef float f32x4 __attribute__((ext_vector_type(4)));
typedef float f32x2 __attribute__((ext_vector_type(2)));
typedef unsigned u32x4 __attribute__((ext_vector_type(4)));
typedef unsigned u32x2 __attribute__((ext_vector_type(2)));

namespace C {
constexpr int MP = 32768, MS = 512, M = 33280, D = 2048, DIN = 9216, DH = 1024, DFF = 5632, DFF2 = 11264, MPAD = 33344, TP = 8192;
constexpr int VTS_LD = 544;
constexpr float EPS = 1e-6f;
constexpr size_t O_Y = 0, O_KP = 68157440, O_VP = 70254592, O_KS = 72351744, O_VS = 72876032, O_SGU = 73400320, O_CP = 73924608, O_CS = 74014720;
constexpr size_t W_SS1 = 0, W_SS2 = 147456, W_SS3 = 294912, W_WSB = 442368;
constexpr size_t W_WIN = 1048576, W_WA = 38797312, W_WB = 42991616, W_WO = 47185920, W_WUP = 55574528, W_WD = 101711872;
constexpr size_t W_QB = 125829120, W_KB = 193986560, W_X1G = W_QB;
constexpr size_t W_B0 = 262144000;
constexpr size_t W_XN = W_B0, W_MB = W_B0, W_VT = 398458880, W_VTS = 465567744, W_UB = 501219328, W_GVBT = 569376768, W_SG = 637665280, W_SB = 910295040;
constexpr size_t W_H = W_B0, W_ACT = 642777088;
constexpr int HALF_ROWS = 16384;
}

__device__ __forceinline__ unsigned cvt_pk_bf16(float lo, float hi) { unsigned r; asm("v_cvt_pk_bf16_f32 %0, %1, %2" : "=v"(r) : "v"(lo), "v"(hi)); return r; }
__device__ __forceinline__ float bf_lo(unsigned w) { return __uint_as_float(w << 16); }
__device__ __forceinline__ float bf_hi(unsigned w) { return __uint_as_float(w & 0xffff0000u); }
__device__ __forceinline__ f32x4 mfma16(bf16x8 a, bf16x8 b, f32x4 c) { return __builtin_amdgcn_mfma_f32_16x16x32_bf16(a, b, c, 0, 0, 0); }
__device__ __forceinline__ bf16x8 pack8(f32x4 a, f32x4 b) { u32x4 w = {cvt_pk_bf16(a[0], a[1]), cvt_pk_bf16(a[2], a[3]), cvt_pk_bf16(b[0], b[1]), cvt_pk_bf16(b[2], b[3])}; return *reinterpret_cast<bf16x8*>(&w); }
__device__ __forceinline__ u32x4 pack8u(f32x4 a, f32x4 b) { u32x4 w = {cvt_pk_bf16(a[0], a[1]), cvt_pk_bf16(a[2], a[3]), cvt_pk_bf16(b[0], b[1]), cvt_pk_bf16(b[2], b[3])}; return w; }
__device__ __forceinline__ f32x2 gelu_pk(f32x2 v) {
    const f32x2 av = __builtin_elementwise_abs(v), d = av * 0.2316418882f + 1.0f;
    f32x2 t; t.x = __builtin_amdgcn_rcpf(d.x); t.y = __builtin_amdgcn_rcpf(d.y);
    f32x2 q = t * 0.5307027145f + (-0.7265760135f); q = q * t + 0.7107068705f; q = q * t + (-0.142248368f); q = q * t + 0.127414796f; q = q * t;
    const f32x2 s = (v * v) * (-0.72134752044f);
    f32x2 e; e.x = __builtin_amdgcn_exp2f(s.x); e.y = __builtin_amdgcn_exp2f(s.y);
    const f32x2 m = v * (q * e), r = v - m;
    f32x2 o; o.x = v.x < 0.f ? m.x : r.x; o.y = v.y < 0.f ? m.y : r.y; return o;
}
__device__ __forceinline__ f32x4 gelu4(f32x4 v) { f32x2 a = gelu_pk((f32x2){v[0], v[1]}), b = gelu_pk((f32x2){v[2], v[3]}); return (f32x4){a.x, a.y, b.x, b.y}; }
__device__ __forceinline__ float sigmoidf_(float x) { return __builtin_amdgcn_rcpf(1.0f + __builtin_amdgcn_exp2f(-1.4426950408889634f * x)); }
__device__ __forceinline__ f32x4 sigmoid4(f32x4 v) { return (f32x4){sigmoidf_(v[0]), sigmoidf_(v[1]), sigmoidf_(v[2]), sigmoidf_(v[3])}; }
__device__ __forceinline__ float dot4(f32x4 a) { return (a[0] * a[0] + a[1] * a[1]) + (a[2] * a[2] + a[3] * a[3]); }

struct Ptrs {
    const float *x_prompt, *x_sample, *cache_k, *cache_v, *cache_conv, *norm_mix_g, *w_in, *rel_bias, *sgu_norm_g, *w_s, *b_s, *w_a, *w_b, *w_out, *norm_ffn_g, *w_up, *conv_w, *conv_b, *w_down, *norm_final_g;
    float* out; unsigned char* ws;
};
struct Params { const float* in[20]; float* out; unsigned char* ws; int ph_lo, ph_hi; };

namespace pg8 {
constexpr int BM = 256, BK = 64, HALF = 128, HTB = HALF * BK * 2, STAGE_BYTES = 8 * HTB, NXCD = 8, WGM = 4;
__device__ __forceinline__ int lds_byte(int r, int c) { const int st = (r >> 4) * 2 + (c >> 5), rr = r & 15, cc = c & 31, ob = rr * 64 + cc * 2; return st * 1024 + (ob ^ (((ob >> 9) & 1) << 5)); }
__device__ __forceinline__ void stage_rc(int b, int& R, int& Cc) { const int st = b / 1024, sb = b % 1024, swz = sb ^ (((sb >> 9) & 1) << 5); R = (st >> 1) * 16 + swz / 64; Cc = (st & 1) * 32 + (swz % 64) / 2; }
__device__ __forceinline__ int perm32(int rho) { const int n = rho >> 4, i = rho & 15; return 8 * (i >> 2) + 4 * n + (i & 3); }

struct Unit { int pm, pn, sub; };
struct Gemm { const bf16_t *A0, *A1, *A2, *A3, *B0, *B1, *B2, *B3; int K; int ldk;
    __device__ __forceinline__ const bf16_t* pa(int s) const { return s == 0 ? A0 : (s == 1 ? A1 : (s == 2 ? A2 : A3)); }
    __device__ __forceinline__ const bf16_t* pb(int s) const { return s == 0 ? B0 : (s == 1 ? B1 : (s == 2 ? B2 : B3)); } };

struct Sched {
    int pm0, nM, nN, nsub, G, c;
    __device__ __forceinline__ bool next(int i, Unit& u) const {
        const int ii = i / nsub, sub = i - ii * nsub; const int nwg = nM * nN;
        const long L = (long)ii * G + c; if (L >= nwg) return false;
        int wgid = (int)L; { const int q = nwg / NXCD, r = nwg % NXCD, xcd = wgid % NXCD, off = wgid / NXCD; wgid = (xcd < r ? xcd * (q + 1) : r * (q + 1) + (xcd - r) * q) + off; }
        const int nig = WGM * nN, gid = wgid / nig, fm = gid * WGM, gsz = (nM - fm) < WGM ? (nM - fm) : WGM;
        u.pm = pm0 + fm + ((wgid % nig) % gsz); u.pn = (wgid % nig) / gsz; u.sub = sub; return true;
    }
};

struct SchedK4 {
    int G, c;
    __device__ __forceinline__ bool next(int i, Unit& u) const { const int L = i * G + c; if (L >= 64) return false; const int tile = L >> 2; u.pm = 128 + (tile & 1); u.pn = tile >> 1; u.sub = L & 3; return true; }
};
template <class Epi, class SchedT>
__device__ __forceinline__ void gemm_phase(LAS unsigned char* lds, const Gemm g, const SchedT& S, const Epi& E) {
    const int tid = threadIdx.x, wid = __builtin_amdgcn_readfirstlane(tid >> 6), lane = tid & 63, wr = wid >> 2, wc = wid & 3, fr = lane & 15, fq = lane >> 4;
    const int K = g.ldk, nt = g.K / BK;
    unsigned voffA[2], voffB[2];
#pragma unroll
    for (int i = 0; i < 2; ++i) { int R, Cc; stage_rc(tid * 16 + i * 8192, R, Cc); const int Rb = (R & ~31) + perm32(R & 31);
        voffA[i] = (unsigned)(R * K + Cc) * 2u; voffB[i] = (unsigned)(Rb * K + Cc) * 2u; }
    const size_t kstep = (size_t)(BK * 2);
    const size_t hstep = (size_t)HALF * K * 2;
    const size_t tstep = 2 * hstep;
    const unsigned ldsw = (unsigned)wid * 1024u;
    const int aoff = lds_byte(wr * 64 + fr, fq * 8), boff = lds_byte(wc * 32 + fr, fq * 8);
#define PG8_SA(b, h) (((b) * 2 + (h)) * HTB)
#define PG8_SB(b, h) ((4 + (b) * 2 + (h)) * HTB)
#define PG8_STAGE(bufoff, gbase, voff) do { _Pragma("unroll") for (int _i = 0; _i < 2; ++_i) \
        __builtin_amdgcn_global_load_lds((const unsigned*)((const char*)(gbase) + (voff)[_i]), (LAS unsigned*)(lds + (bufoff) + ldsw + _i * 8192), 16, 0, 0); } while (0)
#define PG8_LDA(dst, b, h) do { _Pragma("unroll") for (int m = 0; m < 4; ++m) _Pragma("unroll") for (int k = 0; k < 2; ++k) dst[m][k] = *(const LAS bf16x8*)(lds + PG8_SA(b, h) + aoff + m * 2048 + k * 1024); } while (0)
#define PG8_LDB(dst, b, h) do { _Pragma("unroll") for (int n = 0; n < 2; ++n) _Pragma("unroll") for (int k = 0; k < 2; ++k) dst[n][k] = *(const LAS bf16x8*)(lds + PG8_SB(b, h) + boff + n * 2048 + k * 1024); } while (0)
#define PG8_MMA(ai, bj, At, Bt) do { __builtin_amdgcn_s_setprio(1); _Pragma("unroll") for (int m = 0; m < 4; ++m) _Pragma("unroll") for (int n = 0; n < 2; ++n) _Pragma("unroll") for (int k = 0; k < 2; ++k) \
        acc[ai][bj][m][n] = __builtin_amdgcn_mfma_f32_16x16x32_bf16(Bt[n][k], At[m][k], acc[ai][bj][m][n], 0, 0, 0); __builtin_amdgcn_s_setprio(0); } while (0)
#define PG8_WAIT_V(n) asm volatile("s_waitcnt vmcnt(" #n ")" ::: "memory")
#define PG8_WAIT_L(n) asm volatile("s_waitcnt lgkmcnt(" #n ")" ::: "memory")
#define PG8_BAR __builtin_amdgcn_s_barrier()
#define PG8_SCHED __builtin_amdgcn_sched_barrier(0)
    Unit cur, nxt; int ui = 0;
    if (!S.next(0, cur)) return;
    f32x4 acc[2][2][4][2];
#pragma unroll
    for (int a = 0; a < 2; ++a)
#pragma unroll
        for (int b = 0; b < 2; ++b)
#pragma unroll
            for (int m = 0; m < 4; ++m)
#pragma unroll
                for (int n = 0; n < 2; ++n) acc[a][b][m][n] = (f32x4){0.f, 0.f, 0.f, 0.f};
    bf16x8 At[4][2], B0[2][2], B1[2][2];
    const char* cA = (const char*)g.pa(cur.sub) + (size_t)cur.pm * tstep; const char* cB = (const char*)g.pb(cur.sub) + (size_t)cur.pn * tstep;
    PG8_STAGE(PG8_SB(0, 0), cB, voffB); PG8_STAGE(PG8_SB(0, 1), cB + hstep, voffB); PG8_STAGE(PG8_SA(0, 0), cA, voffA); PG8_STAGE(PG8_SA(0, 1), cA + hstep, voffA);
    if (wr == 1) PG8_BAR;
    PG8_WAIT_V(2); PG8_BAR;
    PG8_STAGE(PG8_SB(1, 0), cB + kstep, voffB); PG8_STAGE(PG8_SA(1, 0), cA + kstep, voffA); PG8_STAGE(PG8_SB(1, 1), cB + hstep + kstep, voffB);
    PG8_WAIT_V(6); PG8_BAR;
    for (;;) {
        const bool has_next = S.next(ui + 1, nxt);
        const char* nA = has_next ? (const char*)g.pa(nxt.sub) + (size_t)nxt.pm * tstep : cA; const char* nB = has_next ? (const char*)g.pb(nxt.sub) + (size_t)nxt.pn * tstep : cB;
        for (int t = 0; t < nt; t += 2) {
            const bool last = (t == nt - 2);
            const char* a1 = cA + (size_t)(t + 1) * kstep;
            const char* a2 = last ? nA : cA + (size_t)(t + 2) * kstep; const char* b2 = last ? nB : cB + (size_t)(t + 2) * kstep;
            const char* a3 = a2 + kstep; const char* b3 = b2 + kstep;
            PG8_LDB(B0, 0, 0); PG8_LDB(B1, 0, 1); PG8_SCHED; PG8_LDA(At, 0, 0); PG8_STAGE(PG8_SA(1, 1), a1 + hstep, voffA);
            PG8_WAIT_V(8); PG8_WAIT_L(0); PG8_BAR; PG8_MMA(0, 0, At, B0); PG8_MMA(0, 1, At, B1); PG8_BAR; PG8_SCHED;
            PG8_LDA(At, 0, 1); PG8_STAGE(PG8_SB(0, 0), b2, voffB); PG8_STAGE(PG8_SB(0, 1), b2 + hstep, voffB); PG8_STAGE(PG8_SA(0, 0), a2, voffA);
            PG8_WAIT_V(8); PG8_WAIT_L(0); PG8_BAR; PG8_MMA(1, 0, At, B0); PG8_MMA(1, 1, At, B1); PG8_BAR; PG8_SCHED;
            PG8_LDB(B0, 1, 0); PG8_LDB(B1, 1, 1); PG8_SCHED; PG8_LDA(At, 1, 0); PG8_STAGE(PG8_SA(0, 1), a2 + hstep, voffA);
            PG8_WAIT_V(8); PG8_WAIT_L(0); PG8_BAR; PG8_MMA(0, 0, At, B0); PG8_MMA(0, 1, At, B1); PG8_BAR; PG8_SCHED;
            PG8_LDA(At, 1, 1); PG8_STAGE(PG8_SB(1, 0), b3, voffB); PG8_STAGE(PG8_SB(1, 1), b3 + hstep, voffB); PG8_STAGE(PG8_SA(1, 0), a3, voffA);
            PG8_WAIT_V(8); PG8_WAIT_L(0); PG8_BAR; PG8_MMA(1, 0, At, B0); PG8_MMA(1, 1, At, B1); PG8_BAR; PG8_SCHED;
        }
        if (wr == 0) PG8_BAR;
        const bool reset = E(acc, cur, wr, wc, fr, fq);
        if (!has_next) break;
        if (reset) {
#pragma unroll
            for (int a = 0; a < 2; ++a)
#pragma unroll
                for (int b = 0; b < 2; ++b)
#pragma unroll
                    for (int m = 0; m < 4; ++m)
#pragma unroll
                        for (int n = 0; n < 2; ++n) acc[a][b][m][n] = (f32x4){0.f, 0.f, 0.f, 0.f};
        }
        cur = nxt; cA = nA; cB = nB; ++ui;
        if (wr == 1) PG8_BAR;
    }
    PG8_WAIT_V(0);
    PG8_BAR;
#undef PG8_SA
#undef PG8_SB
#undef PG8_STAGE
#undef PG8_LDA
#undef PG8_LDB
#undef PG8_MMA
#undef PG8_WAIT_V
#undef PG8_WAIT_L
#undef PG8_BAR
#undef PG8_SCHED
}
}

__device__ __forceinline__ void tstore_pair(bf16_t* base  , size_t ld, float a, float b, int e0, bool odd) {
    const float send = odd ? a : b; const float recv = __shfl_xor(send, 1);
    const float lo = odd ? recv : a, hi = odd ? b : recv;
    *(unsigned*)(base + (size_t)(odd ? e0 + 1 : e0) * ld) = cvt_pk_bf16(lo, hi);
}

struct Epi1 {
    bf16_t *qb, *kb, *vT, *vTs, *ub, *gvbT, *sg; float* ssvb; float* out;
    __device__ __forceinline__ bool operator()(f32x4 (&acc)[2][2][4][2], const pg8::Unit& u, int wr, int wc, int fr, int fq) const {
        using namespace C;
        const int pn = u.pn; const int row0 = u.pm * 256 + wr * 64 + fr; const int cl = wc * 32 + 8 * fq;
        if (pn < 8) {
            bf16_t* dst = (pn < 4) ? qb : kb; const int cb = (pn & 3) * 256 + cl;
#pragma unroll
            for (int ai = 0; ai < 2; ++ai)
#pragma unroll
                for (int m = 0; m < 4; ++m) { const int row = row0 + ai * 128 + m * 16;
#pragma unroll
                    for (int bj = 0; bj < 2; ++bj) *(u32x4*)(dst + (size_t)row * 1024 + cb + bj * 128) = pack8u(acc[ai][bj][m][0], acc[ai][bj][m][1]); }
        } else if (pn < 12) {
            const bool odd = fr & 1; const int cb = (pn & 3) * 256 + cl;
#pragma unroll
            for (int ai = 0; ai < 2; ++ai)
#pragma unroll
                for (int m = 0; m < 4; ++m) { const int row = row0 + ai * 128 + m * 16; const int rowe = row & ~1;
                    bf16_t* base; size_t ld;
                    if (row < MP) { const int b = rowe >> 13, t = rowe & 8191; base = vT + (size_t)b * 1024 * 8192 + t; ld = 8192; }
                    else { const int rs = rowe - MP; base = vTs + (size_t)(rs >> 4) * 1024 * VTS_LD + 512 + (rs & 15); ld = VTS_LD; }
#pragma unroll
                    for (int bj = 0; bj < 2; ++bj)
#pragma unroll
                        for (int n = 0; n < 2; ++n)
#pragma unroll
                            for (int e = 0; e < 4; e += 2) tstore_pair(base + (size_t)(cb + bj * 128 + 4 * n) * ld, ld, acc[ai][bj][m][n][e], acc[ai][bj][m][n][e + 1], e, odd); }
        } else if (pn < 16) {
            const int cb = (pn & 3) * 256 + cl;
#pragma unroll
            for (int ai = 0; ai < 2; ++ai)
#pragma unroll
                for (int m = 0; m < 4; ++m) { const int row = row0 + ai * 128 + m * 16;
#pragma unroll
                    for (int bj = 0; bj < 2; ++bj) *(u32x4*)(ub + (size_t)row * 1024 + cb + bj * 128) = pack8u(gelu4(acc[ai][bj][m][0]), gelu4(acc[ai][bj][m][1])); }
        } else if (pn < 20) {
            const bool odd = fr & 1; const int cb = (pn & 3) * 256 + cl;
#pragma unroll
            for (int ai = 0; ai < 2; ++ai)
#pragma unroll
                for (int m = 0; m < 4; ++m) { const int row = row0 + ai * 128 + m * 16; const int rowe = row & ~1; float ss = 0.f;
#pragma unroll
                    for (int bj = 0; bj < 2; ++bj)
#pragma unroll
                        for (int n = 0; n < 2; ++n) { const f32x4 gv = gelu4(acc[ai][bj][m][n]); ss += dot4(gv);
#pragma unroll
                            for (int e = 0; e < 4; e += 2) tstore_pair(gvbT + (size_t)(cb + bj * 128 + 4 * n) * MPAD + rowe, MPAD, gv[e], gv[e + 1], e, odd); }
                    ss += __shfl_xor(ss, 16); ss += __shfl_xor(ss, 32);
                    if (fq == 0) atomicAdd(ssvb + row, ss); }
        } else {
            const int cb = (pn - 20) * 256 + cl;
#pragma unroll
            for (int ai = 0; ai < 2; ++ai)
#pragma unroll
                for (int m = 0; m < 4; ++m) { const int row = row0 + ai * 128 + m * 16;
#pragma unroll
                    for (int bj = 0; bj < 2; ++bj) *(u32x4*)(sg + (size_t)row * 4096 + cb + bj * 128) = pack8u(acc[ai][bj][m][0], acc[ai][bj][m][1]); }
        }
        if (pn >= 4 && pn < 12 && (u.pm >= 128 || (u.pm & 31) >= 30)) {
            const int cb = (pn & 3) * 256 + cl; const bool isv = pn >= 8;
#pragma unroll
            for (int ai = 0; ai < 2; ++ai)
#pragma unroll
                for (int m = 0; m < 4; ++m) { const int row = row0 + ai * 128 + m * 16; float* o;
                    if (row < MP) { const int b = row >> 13, t = row & 8191; o = out + (isv ? O_VP : O_KP) + ((size_t)(b * 512 + (t - 7680))) * 1024 + cb; }
                    else o = out + (isv ? O_VS : O_KS) + (size_t)(row - MP) * 1024 + cb;
#pragma unroll
                    for (int bj = 0; bj < 2; ++bj) { *(f32x4*)(o + bj * 128) = acc[ai][bj][m][0]; *(f32x4*)(o + bj * 128 + 4) = acc[ai][bj][m][1]; } }
        }
        return true;
    }
};

struct Epi2 {
    const bf16_t* sg; bf16_t* mb;
    __device__ __forceinline__ bool operator()(f32x4 (&acc)[2][2][4][2], const pg8::Unit& u, int wr, int wc, int fr, int fq) const {
        const int row0 = u.pm * 256 + wr * 64 + fr; const int cb = u.pn * 256 + wc * 32 + 8 * fq;
        if (u.sub == 0) {
#pragma unroll
            for (int ai = 0; ai < 2; ++ai)
#pragma unroll
                for (int m = 0; m < 4; ++m) { const int row = row0 + ai * 128 + m * 16;
#pragma unroll
                    for (int bj = 0; bj < 2; ++bj) { const u32x4 a = *(const u32x4*)(sg + (size_t)row * 4096 + cb + bj * 128), b = *(const u32x4*)(sg + (size_t)row * 4096 + 2048 + cb + bj * 128);
#pragma unroll
                        for (int w = 0; w < 4; ++w) { const float r0 = sigmoidf_(bf_lo(a[w])) * (1.0f + __builtin_amdgcn_exp2f(-1.4426950408889634f * bf_lo(b[w]))), r1 = sigmoidf_(bf_hi(a[w])) * (1.0f + __builtin_amdgcn_exp2f(-1.4426950408889634f * bf_hi(b[w])));
                            acc[ai][bj][m][w >> 1][(w & 1) * 2] *= r0; acc[ai][bj][m][w >> 1][(w & 1) * 2 + 1] *= r1; } }
                    asm volatile("" ::: "memory"); }
            return false;
        }
#pragma unroll
        for (int ai = 0; ai < 2; ++ai)
#pragma unroll
            for (int m = 0; m < 4; ++m) { const int row = row0 + ai * 128 + m * 16;
#pragma unroll
                for (int bj = 0; bj < 2; ++bj) { const u32x4 b = *(const u32x4*)(sg + (size_t)row * 4096 + 2048 + cb + bj * 128);
                    const f32x4 g0 = sigmoid4((f32x4){bf_lo(b[0]), bf_hi(b[0]), bf_lo(b[1]), bf_hi(b[1])}), g1 = sigmoid4((f32x4){bf_lo(b[2]), bf_hi(b[2]), bf_lo(b[3]), bf_hi(b[3])});
                    *(u32x4*)(mb + (size_t)row * 2048 + cb + bj * 128) = pack8u(acc[ai][bj][m][0] * g0, acc[ai][bj][m][1] * g1); }
                asm volatile("" ::: "memory"); }
        return true;
    }
};

struct Epi3 {
    const float *xp, *xs, *gffn; float* x1; bf16_t* x1g; float* ss2;
    __device__ __forceinline__ bool operator()(f32x4 (&acc)[2][2][4][2], const pg8::Unit& u, int wr, int wc, int fr, int fq) const {
        using namespace C;
        const int row0 = u.pm * 256 + wr * 64 + fr; const int cb = u.pn * 256 + wc * 32 + 8 * fq;
        f32x4 gv[2][2];
#pragma unroll
        for (int bj = 0; bj < 2; ++bj) { gv[bj][0] = *(const f32x4*)(gffn + cb + bj * 128); gv[bj][1] = *(const f32x4*)(gffn + cb + bj * 128 + 4); }
#pragma unroll
        for (int ai = 0; ai < 2; ++ai)
#pragma unroll
            for (int m = 0; m < 4; ++m) { const int row = row0 + ai * 128 + m * 16; const float* xr = (row < MP ? xp + (size_t)row * 2048 : xs + (size_t)(row - MP) * 2048) + cb; float ss = 0.f;
#pragma unroll
                for (int bj = 0; bj < 2; ++bj) { const f32x4 v0 = acc[ai][bj][m][0] + *(const f32x4*)(xr + bj * 128), v1 = acc[ai][bj][m][1] + *(const f32x4*)(xr + bj * 128 + 4);
                    float* o = x1 + (size_t)row * 2048 + cb + bj * 128; *(f32x4*)o = v0; *(f32x4*)(o + 4) = v1; ss += dot4(v0) + dot4(v1);
                    *(u32x4*)(x1g + (size_t)row * 2048 + cb + bj * 128) = pack8u(v0 * gv[bj][0], v1 * gv[bj][1]); }
                ss += __shfl_xor(ss, 16); ss += __shfl_xor(ss, 32);
                if (fq == 0) atomicAdd(ss2 + row, ss); }
        return true;
    }
};

struct Epi4 {
    const float* ss2; bf16_t* hb; float* out; int row_lo;
    __device__ __forceinline__ bool operator()(f32x4 (&acc)[2][2][4][2], const pg8::Unit& u, int wr, int wc, int fr, int fq) const {
        using namespace C;
        const int row0 = u.pm * 256 + wr * 64 + fr; const int cb = u.pn * 256 + wc * 32 + 8 * fq;
#pragma unroll
        for (int ai = 0; ai < 2; ++ai)
#pragma unroll
            for (int m = 0; m < 4; ++m) { const int row = row0 + ai * 128 + m * 16; const float inv = __builtin_amdgcn_rsqf(ss2[row] * (1.0f / 2048.0f) + EPS);
                float* o = nullptr;
                if (row < MP) { if ((row & 8191) >= 8190) o = out + O_CP + (size_t)((row >> 13) * 2 + (row & 8191) - 8190) * DFF2 + cb; }
                else if ((row & 15) >= 14) o = out + O_CS + (size_t)(((row - MP) >> 4) * 2 + (row & 15) - 14) * DFF2 + cb;
#pragma unroll
                for (int bj = 0; bj < 2; ++bj) { const f32x4 v0 = acc[ai][bj][m][0] * inv, v1 = acc[ai][bj][m][1] * inv;
                    *(u32x4*)(hb + (size_t)(row - row_lo) * DFF2 + cb + bj * 128) = pack8u(v0, v1);
                    if (o) { *(f32x4*)(o + bj * 128) = v0; *(f32x4*)(o + bj * 128 + 4) = v1; } } }
        return true;
    }
};

struct Epi5 {
    float* x1; float* ss3;
    __device__ __forceinline__ bool operator()(f32x4 (&acc)[2][2][4][2], const pg8::Unit& u, int wr, int wc, int fr, int fq) const {
        const int row0 = u.pm * 256 + wr * 64 + fr; const int cb = u.pn * 256 + wc * 32 + 8 * fq;
#pragma unroll
        for (int ai = 0; ai < 2; ++ai)
#pragma unroll
            for (int m = 0; m < 4; ++m) { const int row = row0 + ai * 128 + m * 16; float ss = 0.f;
#pragma unroll
                for (int bj = 0; bj < 2; ++bj) { float* o = x1 + (size_t)row * 2048 + cb + bj * 128;
                    const f32x4 v0 = acc[ai][bj][m][0] + *(const f32x4*)o, v1 = acc[ai][bj][m][1] + *(const f32x4*)(o + 4);
                    *(f32x4*)o = v0; *(f32x4*)(o + 4) = v1; ss += dot4(v0) + dot4(v1); }
                ss += __shfl_xor(ss, 16); ss += __shfl_xor(ss, 32);
                if (fq == 0) atomicAdd(ss3 + row, ss); }
        return true;
    }
};

struct Epi5s {
    float* x1;
    __device__ __forceinline__ bool operator()(f32x4 (&acc)[2][2][4][2], const pg8::Unit& u, int wr, int wc, int fr, int fq) const {
        const int row0 = u.pm * 256 + wr * 64 + fr; const int cb = u.pn * 256 + wc * 32 + 8 * fq;
#pragma unroll
        for (int ai = 0; ai < 2; ++ai)
#pragma unroll
            for (int m = 0; m < 4; ++m) { const int row = row0 + ai * 128 + m * 16;
#pragma unroll
                for (int bj = 0; bj < 2; ++bj) { float* o = x1 + (size_t)row * 2048 + cb + bj * 128;
#pragma unroll
                    for (int n = 0; n < 2; ++n)
#pragma unroll
                        for (int e = 0; e < 4; ++e) atomicAdd(o + 4 * n + e, acc[ai][bj][m][n][e]); } }
        return true;
    }
};

__device__ __forceinline__ void transpose_tile(const float* in, int ldi, bf16_t* out, int ldo, int r0, int c0, float* tile) {
    const int tid = threadIdx.x;
#pragma unroll
    for (int i = 0; i < 8; ++i) { const int r = (tid >> 6) + 8 * i, c = tid & 63; tile[r * 65 + c] = in[(size_t)(r0 + r) * ldi + c0 + c]; }
    __syncthreads();
    { const int c = tid >> 3, ro = (tid & 7) * 8; float v[8];
#pragma unroll
      for (int e = 0; e < 8; ++e) v[e] = tile[(ro + e) * 65 + c];
      u32x4 w = {cvt_pk_bf16(v[0], v[1]), cvt_pk_bf16(v[2], v[3]), cvt_pk_bf16(v[4], v[5]), cvt_pk_bf16(v[6], v[7])};
      *(u32x4*)(out + (size_t)(c0 + c) * ldo + r0 + ro) = w; }
    __syncthreads();
}

namespace tt { constexpr int T_IN = 32 * 144, T_A = 16 * 32, T_B = 16 * 32, T_O = 32 * 32, T_UP = 32 * 176, T_D = 88 * 32, T_CV = 32 * 8 * 16;
               constexpr int E0 = T_IN, E1 = E0 + T_A, E2 = E1 + T_B, E3 = E2 + T_O, E4 = E3 + T_UP, E5 = E4 + T_D, E6 = E5 + T_CV; }
__device__ __forceinline__ void transpose_range(const Ptrs& P, float* tile, int t_begin, int t_end, int nblk, int bidx) {
    using namespace C; using namespace tt;
    unsigned char* ws = P.ws;
    for (int t = t_begin + bidx; t < t_end; t += nblk) {
        if (t < E0)      { const int q = t;      transpose_tile(P.w_in, DIN, (bf16_t*)(ws + W_WIN), 2048, (q % 32) * 64, (q / 32) * 64, tile); }
        else if (t < E1) { const int q = t - E0; transpose_tile(P.w_a, 2048, (bf16_t*)(ws + W_WA), 1024, (q % 16) * 64, (q / 16) * 64, tile); }
        else if (t < E2) { const int q = t - E1; transpose_tile(P.w_b, 2048, (bf16_t*)(ws + W_WB), 1024, (q % 16) * 64, (q / 16) * 64, tile); }
        else if (t < E3) { const int q = t - E2; transpose_tile(P.w_out, 2048, (bf16_t*)(ws + W_WO), 2048, (q % 32) * 64, (q / 32) * 64, tile); }
        else if (t < E4) { const int q = t - E3; transpose_tile(P.w_up, DFF2, (bf16_t*)(ws + W_WUP), 2048, (q % 32) * 64, (q / 32) * 64, tile); }
        else if (t < E5) { const int q = t - E4; transpose_tile(P.w_down, 2048, (bf16_t*)(ws + W_WD), DFF, (q % 88) * 64, (q / 88) * 64, tile); }
        else             { const int q = t - E5; const int b = q >> 7, r = q & 127; transpose_tile(P.cache_v + (size_t)b * 512 * 1024, 1024, (bf16_t*)(ws + W_VTS) + (size_t)b * 1024 * VTS_LD, VTS_LD, (r & 7) * 64, (r >> 3) * 64, tile); }
    }
}

__device__ __forceinline__ void phase0(const Ptrs& P, float* tile) {
    using namespace C;
    unsigned char* ws = P.ws;
    const int tid = threadIdx.x, lane = tid & 63, wid = tid >> 6, G = gridDim.x;
    { const size_t gt = (size_t)blockIdx.x * 512 + tid, gn = (size_t)G * 512;
      float* ss = (float*)(ws + W_SS1);
      for (size_t i = gt; i < (size_t)(W_WSB / 4); i += gn) ss[i] = 0.f;
      bf16_t* gvbT = (bf16_t*)(ws + W_GVBT);
      for (size_t i = gt; i < (size_t)1024 * 64; i += gn) gvbT[(i >> 6) * MPAD + M + (i & 63)] = 0;
      bf16_t* vTs = (bf16_t*)(ws + W_VTS);
      for (size_t i = gt; i < (size_t)32 * 1024 * 16; i += gn) vTs[(i >> 4) * VTS_LD + 528 + (i & 15)] = 0;
      bf16_t* wsb = (bf16_t*)(ws + W_WSB);
      for (size_t i = gt; i < (size_t)8 * 128 * 128; i += gn) { const int ii = (int)((i >> 7) & 127), jj = (int)(i & 127); const float v = jj <= ii ? P.w_s[i] : 0.f; wsb[i] = (bf16_t)(cvt_pk_bf16(v, 0.f) & 0xffffu); } }
    { bf16_t* xn = (bf16_t*)(ws + W_XN);
      for (int row = blockIdx.x * 8 + wid; row < M; row += G * 8) {
          const float* x = row < MP ? P.x_prompt + (size_t)row * 2048 : P.x_sample + (size_t)(row - MP) * 2048;
          f32x4 v[8]; float ss = 0.f;
#pragma unroll
          for (int i = 0; i < 4; ++i) { v[2 * i] = *(const f32x4*)(x + i * 512 + lane * 8); v[2 * i + 1] = *(const f32x4*)(x + i * 512 + lane * 8 + 4); ss += dot4(v[2 * i]) + dot4(v[2 * i + 1]); }
#pragma unroll
          for (int o = 32; o >= 1; o >>= 1) ss += __shfl_xor(ss, o);
          const float inv = __builtin_amdgcn_rsqf(ss * (1.0f / 2048.0f) + EPS);
#pragma unroll
          for (int i = 0; i < 4; ++i) { const f32x4 g0 = *(const f32x4*)(P.norm_mix_g + i * 512 + lane * 8), g1 = *(const f32x4*)(P.norm_mix_g + i * 512 + lane * 8 + 4);
              *(u32x4*)(xn + (size_t)row * 2048 + i * 512 + lane * 8) = pack8u(v[2 * i] * inv * g0, v[2 * i + 1] * inv * g1); }
      } }
    transpose_range(P, tile, 0, tt::E0, G, blockIdx.x); transpose_range(P, tile, tt::E5, tt::E6, G, blockIdx.x);
}

constexpr float ATT_C = 0.08838834764831845f * 1.4426950408889634f;

__device__ __forceinline__ void attn_softmax_pv(const f32x4 s0, const f32x4 s1, const LAS float* relb, int d0, bool valid, float& mrun, float& lrun, f32x4 (&o)[8], const bf16x8 (&vf)[8], int fq) {
    float t[8];
#pragma unroll
    for (int j = 0; j < 4; ++j) { int i0 = d0 - j; i0 = (i0 > 256 ? 256 : i0) + 256; int i1 = d0 - 4 - j; i1 = (i1 > 256 ? 256 : i1) + 256;
        t[j] = s0[j] * ATT_C + relb[i0]; t[4 + j] = s1[j] * ATT_C + relb[i1]; }
    if (!valid) {
#pragma unroll
        for (int j = 0; j < 8; ++j) t[j] = -__builtin_inff();
    }
    float tm = fmaxf(fmaxf(fmaxf(t[0], t[1]), fmaxf(t[2], t[3])), fmaxf(fmaxf(t[4], t[5]), fmaxf(t[6], t[7])));
    tm = fmaxf(tm, __shfl_xor(tm, 16)); tm = fmaxf(tm, __shfl_xor(tm, 32));
    const float mn = fmaxf(mrun, tm); const float alpha = __builtin_amdgcn_exp2f(mrun - mn); mrun = mn;
    float ps = 0.f;
#pragma unroll
    for (int j = 0; j < 8; ++j) { t[j] = __builtin_amdgcn_exp2f(t[j] - mn); ps += t[j]; }
    lrun = lrun * alpha + ps;
    float al[4];
#pragma unroll
    for (int jj = 0; jj < 4; ++jj) al[jj] = __shfl(alpha, 4 * fq + jj);
#pragma unroll
    for (int dt = 0; dt < 8; ++dt)
#pragma unroll
        for (int jj = 0; jj < 4; ++jj) o[dt][jj] *= al[jj];
    u32x4 pw = {cvt_pk_bf16(t[0], t[1]), cvt_pk_bf16(t[2], t[3]), cvt_pk_bf16(t[4], t[5]), cvt_pk_bf16(t[6], t[7])};
    const bf16x8 pf = *reinterpret_cast<bf16x8*>(&pw);
#pragma unroll
    for (int dt = 0; dt < 8; ++dt) o[dt] = mfma16(pf, vf[dt], o[dt]);
}
__device__ __forceinline__ void attn_store(bf16_t* ab  , float lrun, const f32x4 (&o)[8], int fr, int fq) {
    float l = lrun; l += __shfl_xor(l, 16); l += __shfl_xor(l, 32);
    const float linv = 1.0f / l;
#pragma unroll
    for (int jj = 0; jj < 4; ++jj) { const float li = __shfl(linv, 4 * fq + jj);
#pragma unroll
        for (int dt = 0; dt < 8; ++dt) { const float v = o[dt][jj] * li; const float vn = __shfl_xor(v, 1);
            if ((fr & 1) == 0) *(unsigned*)(ab + (size_t)(4 * fq + jj) * 1024 + dt * 16 + fr) = cvt_pk_bf16(v, vn); } }
}

__device__ __forceinline__ void attn_prompt_wave(const bf16_t* kb, const bf16_t* vT, bf16_t* qb, const LAS float* relb, int b, int h, int c, int sub, int lane) {
    const int fr = lane & 15, fq = lane >> 4;
    const int qpos0 = c * 64 + sub * 16;
    bf16_t* qrow = qb + ((size_t)b * 8192 + qpos0) * 1024 + h * 128;
    bf16x8 qf[4];
#pragma unroll
    for (int kk = 0; kk < 4; ++kk) qf[kk] = *(const bf16x8*)(qrow + (size_t)fr * 1024 + kk * 32 + fq * 8);
    int kt0 = (c - 8) * 2; if (kt0 < 0) kt0 = 0; const int kt1 = c * 2 + 2;
    const bf16_t* kp = kb + ((size_t)b * 8192 + 8 * (fr >> 2) + (fr & 3)) * 1024 + h * 128 + fq * 8;
    const bf16_t* vp = vT + ((size_t)(b * 1024 + h * 128 + fr)) * 8192 + 8 * fq;
    float mrun = -1e30f, lrun = 0.f; f32x4 o[8];
#pragma unroll
    for (int dt = 0; dt < 8; ++dt) o[dt] = (f32x4){0.f, 0.f, 0.f, 0.f};
    bf16x8 ka[8];
#pragma unroll
    for (int kk = 0; kk < 4; ++kk) { ka[kk] = *(const bf16x8*)(kp + (size_t)kt0 * 32 * 1024 + kk * 32); ka[4 + kk] = *(const bf16x8*)(kp + (size_t)(kt0 * 32 + 4) * 1024 + kk * 32); }
    for (int kt = kt0; kt < kt1; ++kt) {
        bf16x8 vf[8];
#pragma unroll
        for (int dt = 0; dt < 8; ++dt) vf[dt] = *(const bf16x8*)(vp + (size_t)dt * 16 * 8192 + kt * 32);
        f32x4 s0 = {0.f, 0.f, 0.f, 0.f}, s1 = {0.f, 0.f, 0.f, 0.f};
#pragma unroll
        for (int kk = 0; kk < 4; ++kk) { s0 = mfma16(ka[kk], qf[kk], s0); s1 = mfma16(ka[4 + kk], qf[kk], s1); }
        if (kt + 1 < kt1) {
#pragma unroll
            for (int kk = 0; kk < 4; ++kk) { ka[kk] = *(const bf16x8*)(kp + (size_t)(kt + 1) * 32 * 1024 + kk * 32); ka[4 + kk] = *(const bf16x8*)(kp + (size_t)((kt + 1) * 32 + 4) * 1024 + kk * 32); }
        }
        attn_softmax_pv(s0, s1, relb, (qpos0 + fr) - (kt * 32 + 8 * fq), true, mrun, lrun, o, vf, fq);
    }
    attn_store(qrow, lrun, o, fr, fq);
}


constexpr int ATT_KPITCH = 272, ATT_VPITCH = 144, ATT_KBYTES = 64 * ATT_KPITCH, ATT_VBYTES = 128 * ATT_VPITCH, ATT_STAGE = ATT_KBYTES + ATT_VBYTES, ATT_LDS_OFF = 16896;
__device__ __forceinline__ void attn_prompt_pair(const bf16_t* kb, const bf16_t* vT, bf16_t* qb, LAS unsigned char* stg, const LAS float* relb, int b, int h, int cp, int wid, int lane, int tid) {
    const int fr = lane & 15, fq = lane >> 4, half = wid >> 2, c = 2 * cp + half;
    const int qpos0 = c * 64 + (wid & 3) * 16;
    bf16_t* qrow = qb + ((size_t)b * 8192 + qpos0) * 1024 + h * 128;
    bf16x8 qf[4];
#pragma unroll
    for (int kk = 0; kk < 4; ++kk) qf[kk] = *(const bf16x8*)(qrow + (size_t)fr * 1024 + kk * 32 + fq * 8);
    int s_lo = 2 * cp - 8; if (s_lo < 0) s_lo = 0; const int s_hi = 2 * cp + 2;
    const bf16_t* kg = kb + ((size_t)b * 8192 + (tid >> 4)) * 1024 + h * 128 + (tid & 15) * 8;
    const bf16_t* vg = vT + ((size_t)(b * 1024 + h * 128 + (tid >> 2))) * 8192 + (tid & 3) * 16;
    const int k32 = tid >> 4;
    const int kw0 = ((((k32 >> 2) & 1) * 16) + (((k32 >> 3) << 2) | (k32 & 3))) * ATT_KPITCH + (tid & 15) * 16, kw1 = kw0 + 32 * ATT_KPITCH;
    const int vw0 = ATT_KBYTES + (tid >> 2) * ATT_VPITCH + (tid & 3) * 32, vw1 = vw0 + 16;
    const int kr0 = fr * ATT_KPITCH + fq * 16, vr0 = ATT_KBYTES + fr * ATT_VPITCH + fq * 16;
    float mrun = -1e30f, lrun = 0.f; f32x4 o[8];
#pragma unroll
    for (int dt = 0; dt < 8; ++dt) o[dt] = (f32x4){0.f, 0.f, 0.f, 0.f};
    u32x4 st0, st1, st2, st3;
#define ATT_LOAD(s) do { st0 = *(const u32x4*)(kg + (size_t)(s) * 64 * 1024); st1 = *(const u32x4*)(kg + (size_t)((s) * 64 + 32) * 1024); st2 = *(const u32x4*)(vg + (s) * 64); st3 = *(const u32x4*)(vg + (s) * 64 + 8); } while (0)
#define ATT_WRITE(bf) do { LAS unsigned char* w_ = stg + (bf) * ATT_STAGE; *(LAS u32x4*)(w_ + kw0) = st0; *(LAS u32x4*)(w_ + kw1) = st1; *(LAS u32x4*)(w_ + vw0) = st2; *(LAS u32x4*)(w_ + vw1) = st3; } while (0)
    ATT_LOAD(s_lo); ATT_WRITE(0);
    __syncthreads();
    for (int s = s_lo; s < s_hi; ++s) {
        const int cur = (s - s_lo) & 1;
        if (s + 1 < s_hi) ATT_LOAD(s + 1);
        const bool act = half == 0 ? (s <= 2 * cp) : (s >= 2 * cp - 7);
        if (act) {
            const LAS unsigned char* rb = stg + cur * ATT_STAGE;
#pragma unroll
            for (int j = 0; j < 2; ++j) {
                bf16x8 ka[8], vf[8];
#pragma unroll
                for (int kk = 0; kk < 4; ++kk) { ka[kk] = *(const LAS bf16x8*)(rb + kr0 + j * 32 * ATT_KPITCH + kk * 64); ka[4 + kk] = *(const LAS bf16x8*)(rb + kr0 + (j * 32 + 16) * ATT_KPITCH + kk * 64); }
#pragma unroll
                for (int dt = 0; dt < 8; ++dt) vf[dt] = *(const LAS bf16x8*)(rb + vr0 + dt * 16 * ATT_VPITCH + j * 64);
                f32x4 s0 = {0.f, 0.f, 0.f, 0.f}, s1 = {0.f, 0.f, 0.f, 0.f};
#pragma unroll
                for (int kk = 0; kk < 4; ++kk) { s0 = mfma16(ka[kk], qf[kk], s0); s1 = mfma16(ka[4 + kk], qf[kk], s1); }
                attn_softmax_pv(s0, s1, relb, (qpos0 + fr) - ((2 * s + j) * 32 + 8 * fq), true, mrun, lrun, o, vf, fq);
            }
        }
        if (s + 1 < s_hi) ATT_WRITE(cur ^ 1);
        __syncthreads();
    }
#undef ATT_LOAD
#undef ATT_WRITE
    attn_store(qrow, lrun, o, fr, fq);
}

__device__ __forceinline__ void attn_sample_wave(const float* cache_k, const bf16_t* kb, const bf16_t* vTs, bf16_t* qb, const LAS float* relb, int bs, int h, int lane) {
    using namespace C;
    const int fr = lane & 15, fq = lane >> 4;
    bf16_t* qrow = qb + ((size_t)MP + bs * 16) * 1024 + h * 128;
    bf16x8 qf[4];
#pragma unroll
    for (int kk = 0; kk < 4; ++kk) qf[kk] = *(const bf16x8*)(qrow + (size_t)fr * 1024 + kk * 32 + fq * 8);
    const int krow = 8 * (fr >> 2) + (fr & 3);
    const float* ckp = cache_k + ((size_t)bs * 512 + krow) * 1024 + h * 128 + fq * 8;
    const bf16_t* nkp = kb + ((size_t)MP + bs * 16) * 1024 + h * 128 + fq * 8;
    const bf16_t* vp = vTs + ((size_t)(bs * 1024 + h * 128 + fr)) * VTS_LD + 8 * fq;
    float mrun = -1e30f, lrun = 0.f; f32x4 o[8];
#pragma unroll
    for (int dt = 0; dt < 8; ++dt) o[dt] = (f32x4){0.f, 0.f, 0.f, 0.f};
    for (int kt = 0; kt < 17; ++kt) {
        bf16x8 vf[8];
#pragma unroll
        for (int dt = 0; dt < 8; ++dt) vf[dt] = *(const bf16x8*)(vp + (size_t)dt * 16 * VTS_LD + kt * 32);
        bf16x8 ka[8];
        if (kt < 16) {
#pragma unroll
            for (int kk = 0; kk < 4; ++kk) { const float* p0 = ckp + (size_t)kt * 32 * 1024 + kk * 32; const float* p1 = p0 + 4 * 1024;
                ka[kk] = pack8(*(const f32x4*)p0, *(const f32x4*)(p0 + 4)); ka[4 + kk] = pack8(*(const f32x4*)p1, *(const f32x4*)(p1 + 4)); }
        } else {
#pragma unroll
            for (int kk = 0; kk < 4; ++kk) { ka[kk] = *(const bf16x8*)(nkp + (size_t)(krow & 15) * 1024 + kk * 32); ka[4 + kk] = *(const bf16x8*)(nkp + (size_t)((krow + 4) & 15) * 1024 + kk * 32); }
        }
        f32x4 s0 = {0.f, 0.f, 0.f, 0.f}, s1 = {0.f, 0.f, 0.f, 0.f};
#pragma unroll
        for (int kk = 0; kk < 4; ++kk) { s0 = mfma16(ka[kk], qf[kk], s0); s1 = mfma16(ka[4 + kk], qf[kk], s1); }
        attn_softmax_pv(s0, s1, relb, (512 + fr) - (kt * 32 + 8 * fq), kt < 16 || fq < 2, mrun, lrun, o, vf, fq);
    }
    attn_store(qrow, lrun, o, fr, fq);
}

template <bool SAMPLE>
__device__ __forceinline__ void sgu_wave(const Ptrs& P, int r0, int g, int bs, int lane) {
    using namespace C;
    constexpr int NJC = SAMPLE ? 1 : 4, NIT = SAMPLE ? 1 : 8;
    const unsigned char* ws = P.ws;
    const float* ssvb = (const float*)(ws + W_SS1); const bf16_t* gvbT = (const bf16_t*)(ws + W_GVBT); const bf16_t* wsb = (const bf16_t*)(ws + W_WSB);
    const bf16_t* ub = (const bf16_t*)(ws + W_UB); bf16_t* sb = (bf16_t*)(P.ws + W_SB);
    const int fr = lane & 15, fq = lane >> 4;
    float inv[NJC][8];
#pragma unroll
    for (int jc = 0; jc < NJC; ++jc) { const f32x4 a = *(const f32x4*)(ssvb + r0 + jc * 32 + 8 * fq), b = *(const f32x4*)(ssvb + r0 + jc * 32 + 8 * fq + 4);
#pragma unroll
        for (int e = 0; e < 4; ++e) { inv[jc][e] = __builtin_amdgcn_rsqf(a[e] * (1.0f / 1024.0f) + EPS); inv[jc][4 + e] = __builtin_amdgcn_rsqf(b[e] * (1.0f / 1024.0f) + EPS); } }
    bf16x8 wf[NIT][NJC]; float bsv[NIT];
#pragma unroll
    for (int it = 0; it < NIT; ++it) { bsv[it] = P.b_s[g * 128 + it * 16 + fr];
#pragma unroll
        for (int jc = 0; jc < NJC; ++jc) if (jc <= (it >> 1)) wf[it][jc] = *(const bf16x8*)(wsb + (size_t)(g * 128 + it * 16 + fr) * 128 + jc * 32 + 8 * fq); }
    for (int dt = 0; dt < 8; ++dt) {
        const int col = g * 128 + dt * 16 + fr;
        const int cb = g * 128 + dt * 16 + 4 * fq;
        u32x4 raw[NJC]; u32x2 uu[NIT];
#pragma unroll
        for (int jc = 0; jc < NJC; ++jc) raw[jc] = *(const u32x4*)(gvbT + (size_t)col * MPAD + r0 + jc * 32 + 8 * fq);
#pragma unroll
        for (int it = 0; it < NIT; ++it) uu[it] = *(const u32x2*)(ub + (size_t)(r0 + it * 16 + fr) * 1024 + cb);
        const f32x4 gain = *(const f32x4*)(P.sgu_norm_g + cb);
        bf16x8 xf[NJC];
#pragma unroll
        for (int jc = 0; jc < NJC; ++jc) {
            float x[8];
#pragma unroll
            for (int w = 0; w < 4; ++w) { x[2 * w] = bf_lo(raw[jc][w]) * inv[jc][2 * w]; x[2 * w + 1] = bf_hi(raw[jc][w]) * inv[jc][2 * w + 1]; }
            u32x4 pw = {cvt_pk_bf16(x[0], x[1]), cvt_pk_bf16(x[2], x[3]), cvt_pk_bf16(x[4], x[5]), cvt_pk_bf16(x[6], x[7])};
            xf[jc] = *reinterpret_cast<bf16x8*>(&pw);
            if (SAMPLE) { if (fq < 2) { const float gn = P.sgu_norm_g[col];
#pragma unroll
                for (int e = 0; e < 8; ++e) P.out[O_SGU + (size_t)(bs * 16 + 8 * fq + e) * 1024 + col] = x[e] * gn; } } }
#pragma unroll
        for (int it = 0; it < NIT; ++it) {
            f32x4 acc = {0.f, 0.f, 0.f, 0.f};
#pragma unroll
            for (int jc = 0; jc < NJC; ++jc) if (jc <= (it >> 1)) acc = mfma16(xf[jc], wf[it][jc], acc);
            const int row = r0 + it * 16 + fr;
            const float s0 = bf_lo(uu[it][0]) * (acc[0] * gain[0] + bsv[it]), s1 = bf_hi(uu[it][0]) * (acc[1] * gain[1] + bsv[it]), s2 = bf_lo(uu[it][1]) * (acc[2] * gain[2] + bsv[it]), s3 = bf_hi(uu[it][1]) * (acc[3] * gain[3] + bsv[it]);
            u32x2 sw = {cvt_pk_bf16(s0, s1), cvt_pk_bf16(s2, s3)};
            *(u32x2*)(sb + (size_t)row * 1024 + cb) = sw;
        }
    }
}

__device__ __forceinline__ void phase2(const Ptrs& P, LAS float* relb) {
    using namespace C;
    const int tid = threadIdx.x, lane = tid & 63, wid = __builtin_amdgcn_readfirstlane(tid >> 6), G = gridDim.x;
    for (int i = tid; i < 8 * 513; i += 512) relb[(i / 513) * 520 + (i % 513)] = P.rel_bias[i] * 1.4426950408889634f;
    __syncthreads();
    bf16_t* qb = (bf16_t*)(P.ws + W_QB); const bf16_t* kb = (const bf16_t*)(P.ws + W_KB); const bf16_t* vT = (const bf16_t*)(P.ws + W_VT); const bf16_t* vTs = (const bf16_t*)(P.ws + W_VTS);
    constexpr int N_AP = 4 * 8 * 64, N_SGU = 256, N_SGUS = 32, N_AS = 32, N_TOT = N_AP + N_SGU + N_SGUS + N_AS;
    for (int it = blockIdx.x; it < N_TOT; it += G) {
        if (it < N_AP) {
            const int cp = it & 63, h = (it >> 6) & 7, b = it >> 9;
            attn_prompt_pair(kb, vT, qb, (LAS unsigned char*)relb + ATT_LDS_OFF, relb + h * 520, b, h, cp, wid, lane, tid);
        } else if (it < N_AP + N_SGU) {
            const int q = it - N_AP; sgu_wave<false>(P, q * 128, wid, 0, lane);
        } else if (it < N_AP + N_SGU + N_SGUS) {
            const int bs = it - N_AP - N_SGU; sgu_wave<true>(P, MP + bs * 16, wid, bs, lane);
        } else {
            const int bs = it - N_AP - N_SGU - N_SGUS; attn_sample_wave(P.cache_k, kb, vTs, qb, relb + wid * 520, bs, wid, lane);
        }
    }
}

__device__ __forceinline__ void conv_phase(const Ptrs& P, int row_lo, int row_hi) {
    using namespace C;
    const int tid = threadIdx.x, lane = tid & 63, wid = tid >> 6, G = gridDim.x;
    const bf16_t* hb = (const bf16_t*)(P.ws + W_H); bf16_t* act = (bf16_t*)(P.ws + W_ACT);
    const int total = ((row_hi - row_lo) / 16) * 11;
    for (int wi = blockIdx.x * 8 + wid; wi < total; wi += G * 8) {
        const int chunk = wi / 11, slab = wi - chunk * 11; const int r0 = row_lo + chunk * 16; const int c = slab * 512 + lane * 8;
        float cw[2][3][8], cbv[2][8], h1[2][8], h2[2][8];
#pragma unroll
        for (int s = 0; s < 2; ++s) { const int cc = c + s * DFF;
#pragma unroll
            for (int k = 0; k < 3; ++k) { const f32x4 a = *(const f32x4*)(P.conv_w + (size_t)k * DFF2 + cc), b = *(const f32x4*)(P.conv_w + (size_t)k * DFF2 + cc + 4);
#pragma unroll
                for (int e = 0; e < 4; ++e) { cw[s][k][e] = a[e]; cw[s][k][4 + e] = b[e]; } }
            { const f32x4 a = *(const f32x4*)(P.conv_b + cc), b = *(const f32x4*)(P.conv_b + cc + 4);
#pragma unroll
              for (int e = 0; e < 4; ++e) { cbv[s][e] = a[e]; cbv[s][4 + e] = b[e]; } }
            if (r0 >= MP) { const float* p2 = P.cache_conv + (size_t)((r0 - MP) >> 4) * 2 * DFF2 + cc; const float* p1 = p2 + DFF2;
                const f32x4 a2 = *(const f32x4*)p2, b2 = *(const f32x4*)(p2 + 4), a1 = *(const f32x4*)p1, b1 = *(const f32x4*)(p1 + 4);
#pragma unroll
                for (int e = 0; e < 4; ++e) { h2[s][e] = a2[e]; h2[s][4 + e] = b2[e]; h1[s][e] = a1[e]; h1[s][4 + e] = b1[e]; } }
            else if ((r0 & 8191) == 0) {
#pragma unroll
                for (int e = 0; e < 8; ++e) { h2[s][e] = 0.f; h1[s][e] = 0.f; } }
            else { const u32x4 w2 = *(const u32x4*)(hb + (size_t)(r0 - 2 - row_lo) * DFF2 + cc), w1 = *(const u32x4*)(hb + (size_t)(r0 - 1 - row_lo) * DFF2 + cc);
#pragma unroll
                for (int w = 0; w < 4; ++w) { h2[s][2 * w] = bf_lo(w2[w]); h2[s][2 * w + 1] = bf_hi(w2[w]); h1[s][2 * w] = bf_lo(w1[w]); h1[s][2 * w + 1] = bf_hi(w1[w]); } }
        }
#pragma unroll 2
        for (int i = 0; i < 16; ++i) { const int row = r0 + i;
            float hc[2][8], y[2][8];
#pragma unroll
            for (int s = 0; s < 2; ++s) { const u32x4 w0 = *(const u32x4*)(hb + (size_t)(row - row_lo) * DFF2 + c + s * DFF);
#pragma unroll
                for (int w = 0; w < 4; ++w) { hc[s][2 * w] = bf_lo(w0[w]); hc[s][2 * w + 1] = bf_hi(w0[w]); }
#pragma unroll
                for (int e = 0; e < 8; ++e) { y[s][e] = cbv[s][e] + cw[s][0][e] * h2[s][e] + cw[s][1][e] * h1[s][e] + cw[s][2][e] * hc[s][e]; h2[s][e] = h1[s][e]; h1[s][e] = hc[s][e]; } }
            f32x4 g0 = gelu4((f32x4){y[0][0], y[0][1], y[0][2], y[0][3]}), g1 = gelu4((f32x4){y[0][4], y[0][5], y[0][6], y[0][7]});
            const f32x4 v0 = {y[1][0], y[1][1], y[1][2], y[1][3]}, v1 = {y[1][4], y[1][5], y[1][6], y[1][7]};
            *(u32x4*)(act + (size_t)row * DFF + c) = pack8u(g0 * v0, g1 * v1);
        }
    }
}

__device__ __forceinline__ void final_phase(const Ptrs& P) {
    using namespace C;
    const int tid = threadIdx.x, lane = tid & 63, wid = tid >> 6, G = gridDim.x;
    const float* ss3 = (const float*)(P.ws + W_SS3);
    for (int row = blockIdx.x * 8 + wid; row < M; row += G * 8) {
        float* y = P.out + (size_t)row * 2048;
        f32x4 v[8];
#pragma unroll
        for (int i = 0; i < 8; ++i) v[i] = *(const f32x4*)(y + i * 256 + lane * 4);
        float ss;
        if (row >= MP) { ss = 0.f;
#pragma unroll
            for (int i = 0; i < 8; ++i) ss += dot4(v[i]);
#pragma unroll
            for (int o = 32; o >= 1; o >>= 1) ss += __shfl_xor(ss, o); }
        else ss = ss3[row];
        const float inv = __builtin_amdgcn_rsqf(ss * (1.0f / 2048.0f) + EPS);
#pragma unroll
        for (int i = 0; i < 8; ++i) { const int cc = i * 256 + lane * 4; *(f32x4*)(y + cc) = v[i] * inv * *(const f32x4*)(P.norm_final_g + cc); }
    }
}

#define XB_TMO      128
#define XB_XCNT(j)  (256  + 64 * (j))
#define XB_XSUB(j)  (1280 + 64 * (j))
#define XB_XGEN(j)  (2304 + 64 * (j))
#define XB_TOP      3328
#define XB_TOPGEN   3392
#define XCD_BAR_WORDS 3456
#define XB_SPIN_CAP (1u << 18)
constexpr size_t W_XBAR = 720896;
__device__ __forceinline__ unsigned xb_ld(unsigned* p)              { return __hip_atomic_load(p, __ATOMIC_RELAXED, __HIP_MEMORY_SCOPE_AGENT); }
__device__ __forceinline__ unsigned xb_add(unsigned* p, unsigned v) { return __hip_atomic_fetch_add(p, v, __ATOMIC_RELAXED, __HIP_MEMORY_SCOPE_AGENT); }
__device__ __forceinline__ unsigned xb_xcc_id() { return (unsigned)__builtin_amdgcn_s_getreg((3 << 11) | 20) & 0xFu; }
#define XB_SPIN(cond, bar) do { unsigned _sp = 0; while (cond) { __builtin_amdgcn_s_sleep(1); \
    if ((++_sp & 255u) == 0u) { if (xb_ld(&(bar)[XB_TMO])) break; if (_sp > XB_SPIN_CAP) { atomicAdd(&(bar)[XB_TMO], 1u); break; } } } } while (0)
struct XcdBarrier { unsigned* bar; unsigned x; volatile LAS unsigned* st; };
__device__ __forceinline__ XcdBarrier xcd_barrier_post(unsigned* bar, volatile LAS unsigned* st) {
    XcdBarrier b; b.bar = bar; b.x = xb_xcc_id(); b.st = st;
    if (threadIdx.x == 0) (void)xb_add(&bar[XB_XCNT(b.x)], 1u);
    return b;
}
__device__ __forceinline__ void xcd_barrier_complete(unsigned* bar, unsigned x, unsigned& nloc, unsigned& nx) {
    const unsigned G = gridDim.x * gridDim.y * gridDim.z;
    unsigned sum, cnt, mine, sp = 0u;
    for (;;) {
        sum = 0u; cnt = 0u; mine = 0u;
#pragma unroll
        for (unsigned j = 0; j < 16; ++j) { const unsigned c = xb_ld(&bar[XB_XCNT(j)]); sum += c; cnt += (c > 0u) ? 1u : 0u; mine = (j == x) ? c : mine; }
        if (sum == G) break;
        __builtin_amdgcn_s_sleep(1);
        if ((++sp & 255u) == 0u) { if (xb_ld(&bar[XB_TMO])) break; if (sp > XB_SPIN_CAP) { atomicAdd(&bar[XB_TMO], 1u); break; } }
    }
    nloc = mine > 0u ? mine : 1u; nx = cnt > 0u ? cnt : 1u;
}
__device__ __forceinline__ void xcd_barrier(const XcdBarrier& b) {
    asm volatile("s_waitcnt vmcnt(0)" ::: "memory");
    __syncthreads();
    if (threadIdx.x == 0) {
        unsigned* bar = b.bar;
        __builtin_amdgcn_s_waitcnt(0);
        unsigned nloc = b.st[0], nx = b.st[1];
        if (nloc == 0u) { xcd_barrier_complete(bar, b.x, nloc, nx); b.st[0] = nloc; b.st[1] = nx; }
        const unsigned old = xb_add(&bar[XB_XSUB(b.x)], 1u);
        const unsigned gen = old / nloc;
        if (old + 1u == (gen + 1u) * nloc) {
            __builtin_amdgcn_fence(__ATOMIC_RELEASE, "agent");
            asm volatile("s_waitcnt vmcnt(0)" ::: "memory");
            const unsigned og = xb_add(&bar[XB_TOP], 1u);
            const unsigned tg = og / nx;
            if (og + 1u == (tg + 1u) * nx) xb_add(&bar[XB_TOPGEN], 1u);
            else XB_SPIN(xb_ld(&bar[XB_TOPGEN]) == tg, bar);
            __builtin_amdgcn_fence(__ATOMIC_ACQUIRE, "agent");
            xb_add(&bar[XB_XGEN(b.x)], 1u);
            asm volatile("s_waitcnt vmcnt(0)" ::: "memory");
        } else {
            XB_SPIN(xb_ld(&bar[XB_XGEN(b.x)]) == gen, bar);
            __builtin_amdgcn_fence(__ATOMIC_ACQUIRE, "agent");
            asm volatile("s_waitcnt vmcnt(0)" ::: "memory");
        }
    }
    __syncthreads();
}

__global__ void __launch_bounds__(512) mega(Params prm) {
    extern __shared__ __attribute__((aligned(16))) unsigned char lds_raw[];
    using namespace C;
    Ptrs P;
    P.x_prompt = prm.in[0]; P.x_sample = prm.in[1]; P.cache_k = prm.in[2]; P.cache_v = prm.in[3]; P.cache_conv = prm.in[4]; P.norm_mix_g = prm.in[5]; P.w_in = prm.in[6]; P.rel_bias = prm.in[7];
    P.sgu_norm_g = prm.in[8]; P.w_s = prm.in[9]; P.b_s = prm.in[10]; P.w_a = prm.in[11]; P.w_b = prm.in[12]; P.w_out = prm.in[13]; P.norm_ffn_g = prm.in[14]; P.w_up = prm.in[15];
    P.conv_w = prm.in[16]; P.conv_b = prm.in[17]; P.w_down = prm.in[18]; P.norm_final_g = prm.in[19]; P.out = prm.out; P.ws = prm.ws;
    unsigned char* ws = prm.ws;
    LAS unsigned char* lds = (LAS unsigned char*)lds_raw;
    const int lo = prm.ph_lo, hi = prm.ph_hi, G = gridDim.x, bx = blockIdx.x;
#define IN(k) (lo <= (k) && (k) < hi)
    if (lo > 1000) cg::this_grid().sync();
    volatile LAS unsigned* const xst = (volatile LAS unsigned*)(lds + 131072);
    if (threadIdx.x < 4) xst[threadIdx.x] = 0u;
    __syncthreads();
    const XcdBarrier xbar = xcd_barrier_post((unsigned*)(ws + W_XBAR), xst);
#define SEAM(k) do { if (IN(k) && IN((k) + 1)) xcd_barrier(xbar); } while (0)

    if (IN(0)) phase0(P, (float*)lds_raw);
    SEAM(0);
    if (IN(1)) {
        const bf16_t* a = (const bf16_t*)(ws + W_XN); const bf16_t* w = (const bf16_t*)(ws + W_WIN); pg8::Gemm g{a, a, a, a, w, w, w, w, 2048, 2048}; pg8::Sched S{0, 130, 36, 1, G, bx};
        Epi1 E{(bf16_t*)(ws + W_QB), (bf16_t*)(ws + W_KB), (bf16_t*)(ws + W_VT), (bf16_t*)(ws + W_VTS), (bf16_t*)(ws + W_UB), (bf16_t*)(ws + W_GVBT), (bf16_t*)(ws + W_SG), (float*)(ws + W_SS1), P.out};
        pg8::gemm_phase(lds, g, S, E);
        if (bx >= 72) transpose_range(P, (float*)lds_raw, tt::E0, tt::E3, G - 72, bx - 72);
    }
    SEAM(1);
    if (IN(2)) phase2(P, (LAS float*)lds);
    SEAM(2);
    if (IN(3)) {
        const bf16_t *a0 = (const bf16_t*)(ws + W_QB), *a1 = (const bf16_t*)(ws + W_SB), *w0 = (const bf16_t*)(ws + W_WA), *w1 = (const bf16_t*)(ws + W_WB); pg8::Gemm g{a0, a1, a1, a1, w0, w1, w1, w1, 1024, 1024}; pg8::Sched S{0, 130, 8, 2, G, bx};
        Epi2 E{(const bf16_t*)(ws + W_SG), (bf16_t*)(ws + W_MB)};
        pg8::gemm_phase(lds, g, S, E);
        if (bx >= 16) transpose_range(P, (float*)lds_raw, tt::E3, tt::E4, G - 16, bx - 16);
    }
    SEAM(3);
    if (IN(4)) {
        const bf16_t* a = (const bf16_t*)(ws + W_MB); const bf16_t* w = (const bf16_t*)(ws + W_WO); pg8::Gemm g{a, a, a, a, w, w, w, w, 2048, 2048}; pg8::Sched S{0, 130, 8, 1, G, bx};
        Epi3 E{P.x_prompt, P.x_sample, P.norm_ffn_g, P.out, (bf16_t*)(ws + W_X1G), (float*)(ws + W_SS2)};
        pg8::gemm_phase(lds, g, S, E);
        if (bx >= 16) transpose_range(P, (float*)lds_raw, tt::E4, tt::E5, G - 16, bx - 16);
    }
    SEAM(4);
    if (IN(5)) {
        const bf16_t* a = (const bf16_t*)(ws + W_X1G); const bf16_t* w = (const bf16_t*)(ws + W_WUP); pg8::Gemm g{a, a, a, a, w, w, w, w, 2048, 2048}; pg8::Sched S{0, 64, 44, 1, G, bx};
        Epi4 E{(const float*)(ws + W_SS2), (bf16_t*)(ws + W_H), P.out, 0};
        pg8::gemm_phase(lds, g, S, E);
    }
    SEAM(5);
    if (IN(6)) conv_phase(P, 0, HALF_ROWS);
    SEAM(6);
    if (IN(7)) {
        const bf16_t* a = (const bf16_t*)(ws + W_X1G); const bf16_t* w = (const bf16_t*)(ws + W_WUP); pg8::Gemm g{a, a, a, a, w, w, w, w, 2048, 2048}; pg8::Sched S{64, 66, 44, 1, G, bx};
        Epi4 E{(const float*)(ws + W_SS2), (bf16_t*)(ws + W_H), P.out, HALF_ROWS};
        pg8::gemm_phase(lds, g, S, E);
    }
    SEAM(7);
    if (IN(8)) conv_phase(P, HALF_ROWS, M);
    SEAM(8);
    if (IN(9)) {
        const bf16_t* a = (const bf16_t*)(ws + W_ACT); const bf16_t* w = (const bf16_t*)(ws + W_WD);
        { pg8::Gemm g{a, a, a, a, w, w, w, w, 5632, 5632}; pg8::Sched S{0, 128, 8, 1, G, bx};
          Epi5 E{P.out, (float*)(ws + W_SS3)}; pg8::gemm_phase(lds, g, S, E); }
        { pg8::Gemm g{a, a + 1408, a + 2816, a + 4224, w, w + 1408, w + 2816, w + 4224, 1408, 5632}; pg8::SchedK4 S{G, bx};
          Epi5s E{P.out}; pg8::gemm_phase(lds, g, S, E); }
    }
    SEAM(9);
    if (IN(10)) final_phase(P);
#undef IN
#undef SEAM
}

constexpr int N_PHASES = 11;
constexpr int LDS_BYTES = pg8::STAGE_BYTES + 16;

extern "C" void kernel_launch(void* const* d_in, const int* in_sizes, int n_in, void* d_out, int out_size, void* d_ws, size_t ws_size, hipStream_t stream) {
    static int grid = 0;
    if (grid == 0) {
        int dev = 0, cus = 0, per_cu = 0;
        hipGetDevice(&dev);
        hipDeviceGetAttribute(&cus, hipDeviceAttributeMultiprocessorCount, dev);
        if (hipFuncSetAttribute((const void*)mega, hipFuncAttributeMaxDynamicSharedMemorySize, LDS_BYTES) != hipSuccess) { fprintf(stderr, "kernel_launch: hipFuncSetAttribute failed\n"); }
        if (hipOccupancyMaxActiveBlocksPerMultiprocessor(&per_cu, (const void*)mega, 512, LDS_BYTES) != hipSuccess || per_cu < 1) { fprintf(stderr, "kernel_launch: occupancy query says %d\n", per_cu); per_cu = 1; }
        (void)hipGetLastError();
        if (cus <= 0) cus = 256;
        grid = cus;
        if (n_in != 20 || ws_size < C::W_ACT + (size_t)C::M * C::DFF * 2) fprintf(stderr, "kernel_launch: unexpected n_in %d / ws_size %zu\n", n_in, ws_size);
    }
    Params p{};
    for (int i = 0; i < 20; ++i) p.in[i] = (const float*)d_in[i];
    p.out = (float*)d_out; p.ws = (unsigned char*)d_ws;
#if ONE_LAUNCH
    p.ph_lo = 0; p.ph_hi = N_PHASES;
    if (hipMemsetAsync((unsigned char*)d_ws + W_XBAR, 0, XCD_BAR_WORDS * 4, stream) != hipSuccess) fprintf(stderr, "kernel_launch: memset of the barrier words failed\n");
    void* args[] = {&p};
    hipError_t e = hipLaunchCooperativeKernel((const void*)mega, dim3(grid), dim3(512), args, LDS_BYTES, stream);
    if (e != hipSuccess) fprintf(stderr, "cooperative launch failed: %s (grid %d)\n", hipGetErrorString(e), grid);
#else
    for (int k = 0; k < N_PHASES; ++k) { p.ph_lo = k; p.ph_hi = k + 1; hipLaunchKernelGGL(mega, dim3(grid), dim3(512), LDS_BYTES, stream, p); }
#endif
}
```
